# Optimizing an MI355X kernel written in HIP

```python
import math
import jax, jax.numpy as jnp
from jax import lax
import numpy as np

D_MODEL = 1024
BATCH = 32
SEQ = 256
DEPTH = 2
DEC_BATCH = 8
DEC_SEQ = 4096
PAST_LEN = 256

GRID_W = 64
D_MIX = D_MODEL
W_SSM = D_MIX // 4
W_SWA = D_MIX // 4
W_AX = D_MIX // 4
W_FNET = D_MIX - W_SSM - W_SWA - W_AX
HEAD_DIM = 64
N_Q_HEADS = W_SWA // HEAD_DIM
N_KV_HEADS = 2
Q_PER_KV = N_Q_HEADS // N_KV_HEADS
KV_W = N_KV_HEADS * HEAD_DIM
SSM_GROUP = 16
N_SSM_GROUPS = W_SSM // SSM_GROUP
SSM_STATE = 64
WINDOW = 128
Q_BLOCK = 128
ROPE_BASE = 10000.0
D_FF = 2816
N_MOD = 9
EPS = 1e-6
P_IN = W_SSM + W_SWA + 2 * KV_W + W_AX + 2 * KV_W + W_FNET

kernel_name = "hybrid_diffusion_parallel_heads_step"


def rmsnorm(x, g):
    xf = x.astype(jnp.float32)
    y = xf * lax.rsqrt(jnp.mean(xf * xf, axis=-1, keepdims=True) + EPS)
    return (y * g.astype(jnp.float32)).astype(x.dtype)


def swiglu(x, wg, wu, wd):
    return (jax.nn.silu(x @ wg) * (x @ wu)) @ wd


def modulation(cond, w_mod, b_mod):
    m = jax.nn.silu(cond) @ w_mod + b_mod
    return m.reshape(cond.shape[0], 1, N_MOD, D_MODEL)


def axial_rope_tables(n_tokens):
    rows = n_tokens // GRID_W
    row_id = jnp.repeat(jnp.arange(rows), GRID_W).astype(jnp.float32)
    col_id = jnp.tile(jnp.arange(GRID_W), rows).astype(jnp.float32)
    n_freq = HEAD_DIM // 4
    inv = ROPE_BASE ** (-jnp.arange(n_freq, dtype=jnp.float32) / n_freq)
    ang = jnp.concatenate([row_id[:, None] * inv, col_id[:, None] * inv], axis=-1)
    return jnp.cos(ang), jnp.sin(ang)


def apply_rope(x, cos, sin):
    half = HEAD_DIM // 2
    bshape = (cos.shape[0],) + (1,) * (x.ndim - 3) + (half,)
    c = cos.reshape(bshape).astype(x.dtype)
    s = sin.reshape(bshape).astype(x.dtype)
    x1, x2 = x[..., :half], x[..., half:]
    return jnp.concatenate([x1 * c - x2 * s, x2 * c + x1 * s], axis=-1)


def sweep_attention(q, k, v, sink=None, band=False, q_ctx=None, k_ctx=None, v_ctx=None):
    B, L = q.shape[0], q.shape[1]
    scale = HEAD_DIM ** -0.5
    if band:
        pad = ((0, 0), (Q_BLOCK, Q_BLOCK), (0, 0), (0, 0))
        k_src, v_src = jnp.pad(k, pad), jnp.pad(v, pad)

    def one_block(i):
        start = i * Q_BLOCK
        qb = lax.dynamic_slice_in_dim(q, start, Q_BLOCK, axis=1)
        if band:
            kb = lax.dynamic_slice_in_dim(k_src, start, 3 * Q_BLOCK, axis=1)
            vb = lax.dynamic_slice_in_dim(v_src, start, 3 * Q_BLOCK, axis=1)
        else:
            kb, vb = k, v
        logits = jnp.einsum('bqkgd,bskd->bkgqs', qb, kb).astype(jnp.float32) * scale
        if band:
            qpos = start + jnp.arange(Q_BLOCK)
            kpos = start - Q_BLOCK + jnp.arange(3 * Q_BLOCK)
            ok = (kpos[None, :] >= 0) & (kpos[None, :] < L) & (jnp.abs(qpos[:, None] - kpos[None, :]) <= WINDOW)
            logits = jnp.where(ok, logits, -jnp.inf)
        n_main = logits.shape[-1]
        parts = [logits]
        if q_ctx is not None:
            qc = lax.dynamic_slice_in_dim(q_ctx, start, Q_BLOCK, axis=1)
            parts.append(jnp.einsum('bqkgd,bskd->bkgqs', qc, k_ctx).astype(jnp.float32) * scale)
        if sink is not None:
            parts.append(jnp.broadcast_to(sink.astype(jnp.float32)[None, :, :, None, None], logits.shape[:-1] + (1,)))
        probs = jax.nn.softmax(jnp.concatenate(parts, axis=-1), axis=-1)
        out = jnp.einsum('bkgqs,bskd->bqkgd', probs[..., :n_main].astype(vb.dtype), vb)
        if q_ctx is not None:
            n_ctx = k_ctx.shape[1]
            out = out + jnp.einsum('bkgqs,bskd->bqkgd', probs[..., n_main:n_main + n_ctx].astype(v_ctx.dtype), v_ctx)
        return out

    blocks = lax.map(one_block, jnp.arange(L // Q_BLOCK))
    return jnp.moveaxis(blocks, 0, 1).reshape(B, L, q.shape[2], q.shape[3], HEAD_DIM)


def _linear_combine(e1, e2):
    a1, b1 = e1
    a2, b2 = e2
    return a1 * a2, a2 * b1 + b2


def ssm_mixer(u, lam_re, lam_im, b_re, b_im, c_re, c_im, log_dt, d_skip, w_glu, b_glu, s0=None):
    B, L, _ = u.shape
    uf = u.astype(jnp.float32).reshape(B, L, N_SSM_GROUPS, SSM_GROUP)
    lam = lax.complex(lam_re.astype(jnp.float32), lam_im.astype(jnp.float32))
    dt = jnp.exp(log_dt.astype(jnp.float32))[..., None]
    a = jnp.exp(lam * dt)
    b_bar = ((a - 1.0) / lam)[..., None] * lax.complex(b_re.astype(jnp.float32), b_im.astype(jnp.float32))
    c_re32, c_im32 = c_re.astype(jnp.float32), c_im.astype(jnp.float32)
    y = d_skip.astype(jnp.float32) * uf.reshape(B, L, W_SSM)
    finals = []
    for direction in range(2):
        bu = lax.complex(jnp.einsum('blgc,gpc->blgp', uf, jnp.real(b_bar[direction])),
                         jnp.einsum('blgc,gpc->blgp', uf, jnp.imag(b_bar[direction])))
        ad = a[direction]
        edge = 0 if direction == 0 else L - 1
        if s0 is not None:
            bu = bu.at[:, edge].add(ad * s0[:, direction])
        _, states = lax.associative_scan(_linear_combine, (jnp.broadcast_to(ad, bu.shape), bu),
                                         axis=1, reverse=(direction == 1))
        if s0 is None:
            finals.append(states[:, L - 1 - edge])
        y = y + (jnp.einsum('blgp,gcp->blgc', jnp.real(states), c_re32[direction])
                 - jnp.einsum('blgp,gcp->blgc', jnp.imag(states), c_im32[direction])).reshape(B, L, W_SSM)
    y = jax.nn.gelu(y)
    out = (y * jax.nn.sigmoid(y @ w_glu.astype(jnp.float32) + b_glu.astype(jnp.float32))).astype(u.dtype)
    if s0 is None:
        return out, jnp.stack(finals, axis=1)
    return out, None


def fourier_mixer(u, w, b):
    f = jnp.real(jnp.fft.fft2(u.astype(jnp.float32), axes=(1, 2), norm="ortho"))
    return f.astype(u.dtype) @ w + b


def token_mixing(x, p, ctx):
    B, L, _ = x.shape
    proj = x @ p["w_in"]
    sizes = [W_SSM, W_SWA, KV_W, KV_W, W_AX, KV_W, KV_W, W_FNET]
    points, acc = [], 0
    for s in sizes[:-1]:
        acc += s
        points.append(acc)
    u_ssm, q_s, k_s, v_s, q_a, k_a, v_a, u_f = jnp.split(proj, points, axis=-1)
    q_s = q_s.reshape(B, L, N_KV_HEADS, Q_PER_KV, HEAD_DIM)
    k_s = k_s.reshape(B, L, N_KV_HEADS, HEAD_DIM)
    v_s = v_s.reshape(B, L, N_KV_HEADS, HEAD_DIM)
    q_a = rmsnorm(q_a.reshape(B, L, N_KV_HEADS, Q_PER_KV, HEAD_DIM), p["ax_q_norm"])
    k_a = rmsnorm(k_a.reshape(B, L, N_KV_HEADS, HEAD_DIM), p["ax_k_norm"])
    v_a = v_a.reshape(B, L, N_KV_HEADS, HEAD_DIM)
    sink = p["swa_sink"].reshape(N_KV_HEADS, Q_PER_KV)
    ssm_params = (p["ssm_lambda_re"], p["ssm_lambda_im"], p["ssm_b_re"], p["ssm_b_im"],
                  p["ssm_c_re"], p["ssm_c_im"], p["ssm_log_dt"], p["ssm_d"], p["ssm_w_glu"], p["ssm_b_glu"])
    if ctx is None:
        out_a, s_fin = ssm_mixer(u_ssm, *ssm_params, s0=None)
        out_b = sweep_attention(q_s, k_s, v_s, sink=sink)
        out_c = sweep_attention(q_a, k_a, v_a)
        new_ctx = (jnp.stack([k_s, v_s], axis=1),
                   jnp.stack([k_a, v_a], axis=1),
                   jnp.stack([jnp.real(s_fin), jnp.imag(s_fin)], axis=-1))
    else:
        swa_kv, ax_kv, ssm_state = ctx
        s0 = lax.complex(ssm_state[..., 0].astype(jnp.float32), ssm_state[..., 1].astype(jnp.float32))
        out_a, _ = ssm_mixer(u_ssm, *ssm_params, s0=s0)
        cos, sin = axial_rope_tables(L)
        out_b = sweep_attention(apply_rope(q_s, cos, sin), apply_rope(k_s, cos, sin), v_s, sink=sink, band=True,
                                q_ctx=q_s, k_ctx=swa_kv[:, 0], v_ctx=swa_kv[:, 1])
        out_c = sweep_attention(apply_rope(q_a, cos, sin), apply_rope(k_a, cos, sin), v_a,
                                q_ctx=q_a, k_ctx=ax_kv[:, 0], v_ctx=ax_kv[:, 1])
        new_ctx = None
    out_d = fourier_mixer(u_f, p["fnet_w"], p["fnet_b"])
    merged = jnp.concatenate([out_a, out_b.reshape(B, L, W_SWA), out_c.reshape(B, L, W_AX), out_d], axis=-1)
    return merged @ p["w_out"], new_ctx


def trunk_layer(h, cond, p, ctx):
    m = modulation(cond, p["w_mod"], p["b_mod"])
    sh1, sc1, g1, sh2, sc2, g2, sh3, sc3, g3 = [m[:, :, j] for j in range(N_MOD)]
    x = rmsnorm(h, p["norm_ffn1"]) * (1 + sc1) + sh1
    h = h + 0.5 * g1 * swiglu(x, p["ffn1_w_gate"], p["ffn1_w_up"], p["ffn1_w_down"])
    x = rmsnorm(h, p["norm_mix"]) * (1 + sc2) + sh2
    mixed, new_ctx = token_mixing(x, p, ctx)
    h = h + g2 * mixed
    x = rmsnorm(h, p["norm_ffn2"]) * (1 + sc3) + sh3
    h = h + 0.5 * g3 * swiglu(x, p["ffn2_w_gate"], p["ffn2_w_up"], p["ffn2_w_down"])
    return h, new_ctx


def setup_inputs(seed: int = 0) -> dict:
    key = jax.random.key(seed)
    ks = iter(jax.random.split(key, 48))

    def nrm(shape, scale=1.0):
        return jax.random.normal(next(ks), shape, jnp.float32) * scale

    def gain(shape):
        return 1.0 + nrm(shape, 0.05)

    lam_im = jnp.broadcast_to(math.pi * jnp.arange(SSM_STATE, dtype=jnp.float32),
                              (DEPTH, 2, N_SSM_GROUPS, SSM_STATE)) + nrm((DEPTH, 2, N_SSM_GROUPS, SSM_STATE), 0.01)
    log_dt = jax.random.uniform(next(ks), (DEPTH, 2, N_SSM_GROUPS), jnp.float32, math.log(1e-3), math.log(1e-1))
    return {
        "x_prompt": nrm((BATCH, SEQ, D_MODEL)),
        "x_sample": nrm((DEC_BATCH, DEC_SEQ, D_MODEL)),
        "cache_swa_kv": nrm((DEC_BATCH, DEPTH, 2, PAST_LEN, N_KV_HEADS, HEAD_DIM)),
        "cache_axial_kv": nrm((DEC_BATCH, DEPTH, 2, PAST_LEN, N_KV_HEADS, HEAD_DIM)),
        "state_ssm": nrm((DEC_BATCH, DEPTH, 2, N_SSM_GROUPS, SSM_STATE, 2), 0.1),
        "c": nrm((DEC_BATCH, D_MODEL)),
        "c_ctx": nrm((D_MODEL,)),
        "w_mod": nrm((DEPTH, D_MODEL, N_MOD * D_MODEL), 0.5 * D_MODEL ** -0.5),
        "b_mod": nrm((DEPTH, N_MOD * D_MODEL), 0.01),
        "norm_ffn1": gain((DEPTH, D_MODEL)),
        "norm_mix": gain((DEPTH, D_MODEL)),
        "norm_ffn2": gain((DEPTH, D_MODEL)),
        "ffn1_w_gate": nrm((DEPTH, D_MODEL, D_FF), D_MODEL ** -0.5),
        "ffn1_w_up": nrm((DEPTH, D_MODEL, D_FF), D_MODEL ** -0.5),
        "ffn1_w_down": nrm((DEPTH, D_FF, D_MODEL), D_FF ** -0.5),
        "ffn2_w_gate": nrm((DEPTH, D_MODEL, D_FF), D_MODEL ** -0.5),
        "ffn2_w_up": nrm((DEPTH, D_MODEL, D_FF), D_MODEL ** -0.5),
        "ffn2_w_down": nrm((DEPTH, D_FF, D_MODEL), D_FF ** -0.5),
        "w_in": nrm((DEPTH, D_MODEL, P_IN), D_MODEL ** -0.5),
        "w_out": nrm((DEPTH, D_MIX, D_MODEL), D_MIX ** -0.5),
        "ssm_lambda_re": -0.5 + nrm((DEPTH, 2, N_SSM_GROUPS, SSM_STATE), 0.02),
        "ssm_lambda_im": lam_im,
        "ssm_b_re": nrm((DEPTH, 2, N_SSM_GROUPS, SSM_STATE, SSM_GROUP), (2 * SSM_GROUP) ** -0.5),
        "ssm_b_im": nrm((DEPTH, 2, N_SSM_GROUPS, SSM_STATE, SSM_GROUP), (2 * SSM_GROUP) ** -0.5),
        "ssm_c_re": nrm((DEPTH, 2, N_SSM_GROUPS, SSM_GROUP, SSM_STATE), SSM_STATE ** -0.5),
        "ssm_c_im": nrm((DEPTH, 2, N_SSM_GROUPS, SSM_GROUP, SSM_STATE), SSM_STATE ** -0.5),
        "ssm_log_dt": log_dt,
        "ssm_d": nrm((DEPTH, W_SSM)),
        "ssm_w_glu": nrm((DEPTH, W_SSM, W_SSM), W_SSM ** -0.5),
        "ssm_b_glu": nrm((DEPTH, W_SSM), 0.01),
        "swa_sink": nrm((DEPTH, N_Q_HEADS)),
        "ax_q_norm": gain((DEPTH, HEAD_DIM)),
        "ax_k_norm": gain((DEPTH, HEAD_DIM)),
        "fnet_w": nrm((DEPTH, W_FNET, W_FNET), W_FNET ** -0.5),
        "fnet_b": nrm((DEPTH, W_FNET), 0.01),
        "final_norm": gain((D_MODEL,)),
    }


def reference(x_prompt, x_sample, cache_swa_kv, cache_axial_kv, state_ssm, c, c_ctx,
              w_mod, b_mod, norm_ffn1, norm_mix, norm_ffn2,
              ffn1_w_gate, ffn1_w_up, ffn1_w_down, ffn2_w_gate, ffn2_w_up, ffn2_w_down,
              w_in, w_out, ssm_lambda_re, ssm_lambda_im, ssm_b_re, ssm_b_im, ssm_c_re, ssm_c_im,
              ssm_log_dt, ssm_d, ssm_w_glu, ssm_b_glu, swa_sink, ax_q_norm, ax_k_norm,
              fnet_w, fnet_b, final_norm):
    h_ctx, h_lat = x_prompt, x_sample
    swa_list, ax_list, ssm_list = [], [], []
    for l in range(DEPTH):
        p = dict(w_mod=w_mod[l], b_mod=b_mod[l], norm_ffn1=norm_ffn1[l], norm_mix=norm_mix[l],
                 norm_ffn2=norm_ffn2[l], ffn1_w_gate=ffn1_w_gate[l], ffn1_w_up=ffn1_w_up[l],
                 ffn1_w_down=ffn1_w_down[l], ffn2_w_gate=ffn2_w_gate[l], ffn2_w_up=ffn2_w_up[l],
                 ffn2_w_down=ffn2_w_down[l], w_in=w_in[l], w_out=w_out[l],
                 ssm_lambda_re=ssm_lambda_re[l], ssm_lambda_im=ssm_lambda_im[l],
                 ssm_b_re=ssm_b_re[l], ssm_b_im=ssm_b_im[l], ssm_c_re=ssm_c_re[l], ssm_c_im=ssm_c_im[l],
                 ssm_log_dt=ssm_log_dt[l], ssm_d=ssm_d[l], ssm_w_glu=ssm_w_glu[l], ssm_b_glu=ssm_b_glu[l],
                 swa_sink=swa_sink[l], ax_q_norm=ax_q_norm[l], ax_k_norm=ax_k_norm[l],
                 fnet_w=fnet_w[l], fnet_b=fnet_b[l])
        h_ctx, (swa_kv, ax_kv, s_state) = trunk_layer(h_ctx, c_ctx[None, :], p, None)
        swa_list.append(swa_kv)
        ax_list.append(ax_kv)
        ssm_list.append(s_state)
        h_lat, _ = trunk_layer(h_lat, c, p, (cache_swa_kv[:, l], cache_axial_kv[:, l], state_ssm[:, l]))
    y_prompt = rmsnorm(h_ctx, final_norm)
    y_sample = rmsnorm(h_lat, final_norm)
    new_swa_kv = jnp.stack(swa_list, axis=1)
    new_axial_kv = jnp.stack(ax_list, axis=1)
    new_state_ssm = jnp.stack(ssm_list, axis=1)
    return (y_prompt, y_sample, new_swa_kv, new_axial_kv, new_state_ssm)
```

```cpp
#include <hip/hip_runtime.h>
#include <hip/hip_cooperative_groups.h>
#include <cstdio>
#include <cstdint>
namespace cg = cooperative_groups;

#define DI __device__ __forceinline__
#define LAS __attribute__((address_space(3)))
typedef unsigned short bf16_t;
typedef short bf16x8 __attribute__((ext_vector_type(8)));
typedef float f32x4 __attribute__((ext_vector_type(4)));
typedef float f32x2 __attribute__((ext_vector_type(2)));
typedef float f32x16 __attribute__((ext_vector_type(16)));
typedef unsigned u32x4 __attribute__((ext_vector_type(4)));
typedef unsigned u32x2 __attribute__((ext_vector_type(2)));

constexpr int DM = 1024, FF = 2816, T_CTX = 8192, T_LAT = 32768, T_ALL = 40960, NPROJ = 1280, NMOD = 9;
constexpr int NTHREADS = 512, NWAVES = 8;
constexpr float EPSF = 1e-6f;
constexpr float C2 = 0.125f * 1.4426950408889634f;
constexpr float LOG2E = 1.4426950408889634f;

constexpr size_t SZ_WGU = (size_t)2 * FF * DM * 2, SZ_WDN = (size_t)DM * FF * 2;
constexpr size_t OFF_WGU = 0;
constexpr size_t OFF_WDN = OFF_WGU + 4 * SZ_WGU;
constexpr size_t OFF_WIN = OFF_WDN + 4 * SZ_WDN;
constexpr size_t OFF_WINF = OFF_WIN + 2 * (size_t)NPROJ * DM * 2;
constexpr size_t OFF_WOUT = OFF_WINF + 2 * (size_t)512 * DM * 2;
constexpr size_t OFF_WGLU = OFF_WOUT + 2 * (size_t)DM * DM * 2;
constexpr size_t OFF_WFN = OFF_WGLU + 2 * (size_t)256 * 256 * 2;
constexpr size_t OFF_TC4 = OFF_WFN + 2 * (size_t)256 * 1024 * 2;
constexpr size_t OFF_TS4 = OFF_TC4 + (size_t)2056 * 4096 * 2;
constexpr size_t OFF_TC2 = OFF_TS4 + (size_t)2056 * 4096 * 2;
constexpr size_t OFF_TS2 = OFF_TC2 + (size_t)256 * 256 * 2;
constexpr size_t OFF_MOD = OFF_TS2 + (size_t)256 * 256 * 2;
constexpr size_t OFF_ROPE = OFF_MOD + (size_t)2 * 9 * 9216 * 4;
constexpr size_t OFF_CKV = OFF_ROPE + (size_t)4096 * 32 * 8;
constexpr size_t OFF_ESTC = OFF_CKV + (size_t)2 * 2 * 8 * 2 * 256 * 128 * 2;
constexpr size_t OFF_ESTL = OFF_ESTC + (size_t)32 * 16 * 2 * 2 * 64 * 8;
constexpr size_t OFF_XN = OFF_ESTL + (size_t)8 * 16 * 2 * 32 * 64 * 8;
constexpr size_t OFF_HB = OFF_XN;
constexpr size_t OFF_FCS = OFF_XN;
constexpr size_t OFF_HID = OFF_XN + (size_t)T_ALL * DM * 2;
constexpr size_t OFF_PROJ = OFF_HID;
constexpr size_t OFF_MERGED = OFF_PROJ + (size_t)T_ALL * NPROJ * 2;
constexpr size_t OFF_PQT = OFF_MERGED + (size_t)T_ALL * DM * 2;
constexpr size_t WS_END = OFF_HID + (size_t)T_ALL * FF * 2;
constexpr size_t OFF_CTL = WS_END, CTL_BYTES = 16384;
constexpr size_t OFF_W128 = WS_END + CTL_BYTES;
constexpr size_t OFF_YS = OFF_W128 + (size_t)2 * 2 * 16 * 128 * 2048 * 2;
constexpr size_t OFF_KR = OFF_YS + (size_t)T_ALL * 256 * 2;
constexpr size_t WS_TOTAL = OFF_KR + (size_t)T_ALL * 256 * 2;
static_assert(OFF_PQT + (size_t)512 * T_ALL * 2 <= WS_END, "overlay");
static_assert(WS_TOTAL <= (size_t)536870912, "ws budget");
static_assert(OFF_XN % 256 == 0 && OFF_HID % 256 == 0 && OFF_TC4 % 256 == 0, "align");

constexpr size_t OUT_SWA = (size_t)T_ALL * DM;
constexpr size_t OUT_AX = OUT_SWA + (size_t)32 * 2 * 2 * 256 * 128;
constexpr size_t OUT_SSM = OUT_AX + (size_t)32 * 2 * 2 * 256 * 128;

constexpr int LDS_BYTES = 131072 + 1024;

struct Params { const float* in[36]; float* out; unsigned char* ws; };

DI unsigned cvt_pk_bf16(float lo, float hi) { unsigned r; asm volatile("v_cvt_pk_bf16_f32 %0, %1, %2" : "=v"(r) : "v"(lo), "v"(hi)); return r; }
typedef __bf16 bf16x2_t __attribute__((ext_vector_type(2)));
DI unsigned cvt_pk_bf16_c(float lo, float hi) { const f32x2 v = {lo, hi}; const bf16x2_t b = __builtin_convertvector(v, bf16x2_t); return __builtin_bit_cast(unsigned, b); }
DI unsigned f2bf(float f) { unsigned u = __float_as_uint(f); return (u + 0x7fffu + ((u >> 16) & 1u)) >> 16; }
DI float bflo(unsigned w) { return __uint_as_float(w << 16); }
DI float bfhi(unsigned w) { return __uint_as_float(w & 0xffff0000u); }
DI float bf1(bf16_t v) { return __uint_as_float(((unsigned)v) << 16); }
DI float shx(float v, int o, int lane) { return __int_as_float(__builtin_amdgcn_ds_bpermute((lane ^ o) << 2, __float_as_int(v))); }
DI float wave_sum(float v, int lane) {
#pragma unroll
    for (int o = 1; o < 64; o <<= 1) v += shx(v, o, lane);
    return v;
}
DI int fresh(int v) { asm volatile("" : "+v"(v)); return v; }
DI float silu_f(float x) { return x / (1.f + __expf(-x)); }
DI float sigmoid_f(float x) { return 1.f / (1.f + __expf(-x)); }
DI float gelu_tanh(float x) { const float z = 0.7978845608028654f * (x + 0.044715f * x * x * x); const float e = __expf(2.f * z); return 0.5f * x * (2.f - 2.f / (e + 1.f)); }

namespace pg8 {
constexpr int BM = 256, BK = 64, HALF = 128, HTB = HALF * BK * 2, NXCD = 8, WGM = 8;
__host__ __device__ __forceinline__ int lds_byte(int r, int c) { const int st = (r >> 4) * 2 + (c >> 5), rr = r & 15, cc = c & 31, ob = rr * 64 + cc * 2; return st * 1024 + (ob ^ (((ob >> 9) & 1) << 5)); }
__host__ __device__ __forceinline__ void stage_rc(int b, int& R, int& C) { const int st = b / 1024, sb = b % 1024, swz = sb ^ (((sb >> 9) & 1) << 5); R = (st >> 1) * 16 + swz / 64; C = (st & 1) * 32 + (swz % 64) / 2; }
__host__ __device__ __forceinline__ int perm32(int rho) { const int n = rho >> 4, i = rho & 15; return 8 * (i >> 2) + 4 * n + (i & 3); }

struct Unit { const char* A; const char* B; int pm, pn; };
struct Cfg { unsigned lda, ldb; int K; };

struct SchedStd {
    const char* A; const char* B; unsigned lda, ldb; int nM, nN, nwg, G, c;
    DI void init(const void* A_, const void* B_, unsigned lda_, unsigned ldb_, int M, int N, int G_, int c_) { A = (const char*)A_; B = (const char*)B_; lda = lda_; ldb = ldb_; nM = M / BM; nN = N / BM; nwg = nM * nN; G = G_; c = c_; }
    DI bool next(int i, Unit& u) const {
        const long L = (long)i * G + c; if (L >= nwg) return false;
        int wgid = (int)L; { const int q = nwg / NXCD, r = nwg % NXCD, xcd = wgid % NXCD, off = wgid / NXCD; wgid = (xcd < r ? xcd * (q + 1) : r * (q + 1) + (xcd - r) * q) + off; }
        const int nig = WGM * nN, gid = wgid / nig, fm = gid * WGM, gsz = (nM - fm) < WGM ? (nM - fm) : WGM;
        u.pm = fm + ((wgid % nig) % gsz); u.pn = (wgid % nig) / gsz;
        u.A = A + (size_t)u.pm * BM * lda; u.B = B + (size_t)u.pn * BM * ldb; return true;
    }
};

template <bool PERM, class Sched, class Epi>
DI void gemm_phase(LAS unsigned char* lds, const int tid, const Cfg g, const Sched& S, const Epi& E) {
    const int wid = __builtin_amdgcn_readfirstlane(tid >> 6), lane = tid & 63, wr = wid >> 2, wc = wid & 3, fr = lane & 15, fq = lane >> 4;
    const int nt = g.K / BK;
    unsigned voffA[2], voffB[2];
#pragma unroll
    for (int i = 0; i < 2; ++i) { int R, C; stage_rc(tid * 16 + i * 8192, R, C); const int Rb = PERM ? ((R & ~31) + perm32(R & 31)) : R;
        voffA[i] = (unsigned)R * g.lda + (unsigned)C * 2u; voffB[i] = (unsigned)Rb * g.ldb + (unsigned)C * 2u; }
    const size_t kstep = (size_t)(BK * 2);
    const size_t hsA = (size_t)HALF * g.lda, hsB = (size_t)HALF * g.ldb;
    const unsigned ldsw = (unsigned)wid * 1024u;
    const int aoff = lds_byte(wr * 64 + fr, fq * 8), boff = lds_byte(wc * 32 + fr, fq * 8);
#define PG8_SA(b, h) (((b) * 2 + (h)) * HTB)
#define PG8_SB(b, h) ((4 + (b) * 2 + (h)) * HTB)
#define PG8_STAGE(bufoff, gbase, voff) do { const char* _gb = (const char*)(gbase); asm volatile("" : "+s"(_gb));   \
        _Pragma("unroll") for (int _i = 0; _i < 2; ++_i) \
        __builtin_amdgcn_global_load_lds((const unsigned*)(_gb + (voff)[_i]), (LAS unsigned*)(lds + (bufoff) + ldsw + _i * 8192), 16, 0, 0); } while (0)
#define PG8_LDA(dst, b, h) do { _Pragma("unroll") for (int m = 0; m < 4; ++m) _Pragma("unroll") for (int k = 0; k < 2; ++k) dst[m][k] = *(const LAS bf16x8*)(lds + PG8_SA(b, h) + aoff + m * 2048 + k * 1024); } while (0)
#define PG8_LDB(dst, b, h) do { _Pragma("unroll") for (int n = 0; n < 2; ++n) _Pragma("unroll") for (int k = 0; k < 2; ++k) dst[n][k] = *(const LAS bf16x8*)(lds + PG8_SB(b, h) + boff + n * 2048 + k * 1024); } while (0)
#define PG8_MMA(ai, bj, At, Bt) do { __builtin_amdgcn_s_setprio(1); _Pragma("unroll") for (int m = 0; m < 4; ++m) _Pragma("unroll") for (int n = 0; n < 2; ++n) _Pragma("unroll") for (int k = 0; k < 2; ++k) \
        acc[ai][bj][m][n] = __builtin_amdgcn_mfma_f32_16x16x32_bf16(Bt[n][k], At[m][k], acc[ai][bj][m][n], 0, 0, 0); __builtin_amdgcn_s_setprio(0); } while (0)
#define PG8_WAIT_V(n) asm volatile("s_waitcnt vmcnt(" #n ")" ::: "memory")
#define PG8_WAIT_L(n) asm volatile("s_waitcnt lgkmcnt(" #n ")" ::: "memory")
#define PG8_BAR __builtin_amdgcn_s_barrier()
#define PG8_SCHED __builtin_amdgcn_sched_barrier(0)
    Unit cur, nxt; int ui = 0;
    if (!S.next(0, cur)) return;
    f32x4 acc[2][2][4][2];
#pragma unroll
    for (int a = 0; a < 2; ++a)
#pragma unroll
        for (int b = 0; b < 2; ++b)
#pragma unroll
            for (int m = 0; m < 4; ++m)
#pragma unroll
                for (int n = 0; n < 2; ++n) acc[a][b][m][n] = (f32x4){0.f, 0.f, 0.f, 0.f};
    bf16x8 At[4][2], B0[2][2], B1[2][2];
    const char* cA = cur.A; const char* cB = cur.B;
    PG8_STAGE(PG8_SB(0, 0), cB, voffB); PG8_STAGE(PG8_SB(0, 1), cB + hsB, voffB); PG8_STAGE(PG8_SA(0, 0), cA, voffA); PG8_STAGE(PG8_SA(0, 1), cA + hsA, voffA);
    if (wr == 1) PG8_BAR;
    PG8_WAIT_V(2); PG8_BAR;
    PG8_STAGE(PG8_SB(1, 0), cB + kstep, voffB); PG8_STAGE(PG8_SA(1, 0), cA + kstep, voffA); PG8_STAGE(PG8_SB(1, 1), cB + hsB + kstep, voffB);
    PG8_WAIT_V(6); PG8_BAR;
    for (;;) {
        const bool has_next = S.next(ui + 1, nxt);
        const char* nA = has_next ? nxt.A : cA; const char* nB = has_next ? nxt.B : cB;
        for (int t = 0; t < nt; t += 2) {
            const bool last = (t == nt - 2);
            const char* a1 = cA + (size_t)(t + 1) * kstep;
            const char* a2 = last ? nA : cA + (size_t)(t + 2) * kstep; const char* b2 = last ? nB : cB + (size_t)(t + 2) * kstep;
            const char* a3 = a2 + kstep; const char* b3 = b2 + kstep;
            PG8_LDB(B0, 0, 0); PG8_LDB(B1, 0, 1); PG8_SCHED; PG8_LDA(At, 0, 0); PG8_STAGE(PG8_SA(1, 1), a1 + hsA, voffA);
            PG8_WAIT_V(8); PG8_WAIT_L(0); PG8_BAR; PG8_MMA(0, 0, At, B0); PG8_MMA(0, 1, At, B1); PG8_BAR; PG8_SCHED;
            PG8_LDA(At, 0, 1); PG8_STAGE(PG8_SB(0, 0), b2, voffB); PG8_STAGE(PG8_SB(0, 1), b2 + hsB, voffB); PG8_STAGE(PG8_SA(0, 0), a2, voffA);
            PG8_WAIT_V(8); PG8_WAIT_L(0); PG8_BAR; PG8_MMA(1, 0, At, B0); PG8_MMA(1, 1, At, B1); PG8_BAR; PG8_SCHED;
            PG8_LDB(B0, 1, 0); PG8_LDB(B1, 1, 1); PG8_SCHED; PG8_LDA(At, 1, 0); PG8_STAGE(PG8_SA(0, 1), a2 + hsA, voffA);
            PG8_WAIT_V(8); PG8_WAIT_L(0); PG8_BAR; PG8_MMA(0, 0, At, B0); PG8_MMA(0, 1, At, B1); PG8_BAR; PG8_SCHED;
            PG8_LDA(At, 1, 1); PG8_STAGE(PG8_SB(1, 0), b3, voffB); PG8_STAGE(PG8_SB(1, 1), b3 + hsB, voffB); PG8_STAGE(PG8_SA(1, 0), a3, voffA);
            PG8_WAIT_V(8); PG8_WAIT_L(0); PG8_BAR; PG8_MMA(1, 0, At, B0); PG8_MMA(1, 1, At, B1); PG8_BAR; PG8_SCHED;
        }
        if (wr == 0) PG8_BAR;
        E(acc, cur, wr, wc, fr, fq);
        if (!has_next) break;
#pragma unroll
        for (int a = 0; a < 2; ++a)
#pragma unroll
            for (int b = 0; b < 2; ++b)
#pragma unroll
                for (int m = 0; m < 4; ++m)
#pragma unroll
                    for (int n = 0; n < 2; ++n) acc[a][b][m][n] = (f32x4){0.f, 0.f, 0.f, 0.f};
        cur = nxt; cA = nA; cB = nB; ++ui;
        if (wr == 1) PG8_BAR;
    }
    PG8_WAIT_V(0);
    PG8_BAR;
#undef PG8_SA
#undef PG8_SB
#undef PG8_STAGE
#undef PG8_LDA
#undef PG8_LDB
#undef PG8_MMA
#undef PG8_WAIT_V
#undef PG8_WAIT_L
#undef PG8_BAR
#undef PG8_SCHED
}

template <bool PERM, class Sched, class Epi>
DI void gemm_phase_hn(LAS unsigned char* lds, const int tid, const Cfg g, const Sched& S, const Epi& E) {
    const int wid = __builtin_amdgcn_readfirstlane(tid >> 6), lane = tid & 63, wr = wid >> 2, wc = wid & 3, fr = lane & 15, fq = lane >> 4;
    const int nt = g.K / BK;
    unsigned voffA[2], voffB[2];
#pragma unroll
    for (int i = 0; i < 2; ++i) { int R, C; stage_rc(tid * 16 + i * 8192, R, C); const int Rb = PERM ? ((R & ~31) + perm32(R & 31)) : R;
        voffA[i] = (unsigned)R * g.lda + (unsigned)C * 2u; voffB[i] = (unsigned)Rb * g.ldb + (unsigned)C * 2u; }
    const size_t kstep = (size_t)(BK * 2);
    const size_t hsA = (size_t)HALF * g.lda;
    const unsigned ldsw = (unsigned)wid * 1024u;
    const int aoff = lds_byte(wr * 64 + fr, fq * 8), boff = lds_byte(wc * 32 + fr, fq * 8);
#define PG8_SA(b, h) (((b) * 2 + (h)) * HTB)
#define PG8_SB(b, h) ((4 + (b) * 2 + (h)) * HTB)
#define PG8_STAGE(bufoff, gbase, voff) do { const char* _gb = (const char*)(gbase); asm volatile("" : "+s"(_gb));   \
        _Pragma("unroll") for (int _i = 0; _i < 2; ++_i) \
        __builtin_amdgcn_global_load_lds((const unsigned*)(_gb + (voff)[_i]), (LAS unsigned*)(lds + (bufoff) + ldsw + _i * 8192), 16, 0, 0); } while (0)
#define PG8_LDA(dst, b, h) do { _Pragma("unroll") for (int m = 0; m < 4; ++m) _Pragma("unroll") for (int k = 0; k < 2; ++k) dst[m][k] = *(const LAS bf16x8*)(lds + PG8_SA(b, h) + aoff + m * 2048 + k * 1024); } while (0)
#define PG8_LDB(dst, b, h) do { _Pragma("unroll") for (int n = 0; n < 2; ++n) _Pragma("unroll") for (int k = 0; k < 2; ++k) dst[n][k] = *(const LAS bf16x8*)(lds + PG8_SB(b, h) + boff + n * 2048 + k * 1024); } while (0)
#define PG8_MMA(ai, bj, At, Bt) do { __builtin_amdgcn_s_setprio(1); _Pragma("unroll") for (int m = 0; m < 4; ++m) _Pragma("unroll") for (int n = 0; n < 2; ++n) _Pragma("unroll") for (int k = 0; k < 2; ++k) \
        acc[ai][bj][m][n] = __builtin_amdgcn_mfma_f32_16x16x32_bf16(Bt[n][k], At[m][k], acc[ai][bj][m][n], 0, 0, 0); __builtin_amdgcn_s_setprio(0); } while (0)
#define PG8_WAIT_V(n) asm volatile("s_waitcnt vmcnt(" #n ")" ::: "memory")
#define PG8_WAIT_L(n) asm volatile("s_waitcnt lgkmcnt(" #n ")" ::: "memory")
#define PG8_BAR __builtin_amdgcn_s_barrier()
#define PG8_SCHED __builtin_amdgcn_sched_barrier(0)
    Unit cur, nxt; int ui = 0;
    if (!S.next(0, cur)) return;
    f32x4 acc[2][1][4][2];
#pragma unroll
    for (int a = 0; a < 2; ++a)
#pragma unroll
        for (int b = 0; b < 1; ++b)
#pragma unroll
            for (int m = 0; m < 4; ++m)
#pragma unroll
                for (int n = 0; n < 2; ++n) acc[a][b][m][n] = (f32x4){0.f, 0.f, 0.f, 0.f};
    bf16x8 At[4][2], B0[2][2];
    const char* cA = cur.A; const char* cB = cur.B;
    PG8_STAGE(PG8_SB(0, 0), cB, voffB); PG8_STAGE(PG8_SA(0, 0), cA, voffA); PG8_STAGE(PG8_SA(0, 1), cA + hsA, voffA);
    if (wr == 1) PG8_BAR;
    PG8_WAIT_V(2); PG8_BAR;
    PG8_STAGE(PG8_SB(1, 0), cB + kstep, voffB); PG8_STAGE(PG8_SA(1, 0), cA + kstep, voffA);
    PG8_WAIT_V(4); PG8_BAR;
    for (;;) {
        const bool has_next = S.next(ui + 1, nxt);
        const char* nA = has_next ? nxt.A : cA; const char* nB = has_next ? nxt.B : cB;
        for (int t = 0; t < nt; t += 2) {
            const bool last = (t == nt - 2);
            const char* a1 = cA + (size_t)(t + 1) * kstep;
            const char* a2 = last ? nA : cA + (size_t)(t + 2) * kstep; const char* b2 = last ? nB : cB + (size_t)(t + 2) * kstep;
            const char* a3 = a2 + kstep; const char* b3 = b2 + kstep;
            PG8_LDB(B0, 0, 0); PG8_SCHED; PG8_LDA(At, 0, 0); PG8_STAGE(PG8_SA(1, 1), a1 + hsA, voffA);
            PG8_WAIT_V(6); PG8_WAIT_L(0); PG8_BAR; PG8_MMA(0, 0, At, B0); PG8_BAR; PG8_SCHED;
            PG8_LDA(At, 0, 1); PG8_STAGE(PG8_SB(0, 0), b2, voffB); PG8_STAGE(PG8_SA(0, 0), a2, voffA);
            PG8_WAIT_V(6); PG8_WAIT_L(0); PG8_BAR; PG8_MMA(1, 0, At, B0); PG8_BAR; PG8_SCHED;
            PG8_LDB(B0, 1, 0); PG8_SCHED; PG8_LDA(At, 1, 0); PG8_STAGE(PG8_SA(0, 1), a2 + hsA, voffA);
            PG8_WAIT_V(6); PG8_WAIT_L(0); PG8_BAR; PG8_MMA(0, 0, At, B0); PG8_BAR; PG8_SCHED;
            PG8_LDA(At, 1, 1); PG8_STAGE(PG8_SB(1, 0), b3, voffB); PG8_STAGE(PG8_SA(1, 0), a3, voffA);
            PG8_WAIT_V(6); PG8_WAIT_L(0); PG8_BAR; PG8_MMA(1, 0, At, B0); PG8_BAR; PG8_SCHED;
        }
        if (wr == 0) PG8_BAR;
        E(acc, cur, wr, wc, fr, fq);
        if (!has_next) break;
#pragma unroll
        for (int a = 0; a < 2; ++a)
#pragma unroll
            for (int b = 0; b < 1; ++b)
#pragma unroll
                for (int m = 0; m < 4; ++m)
#pragma unroll
                    for (int n = 0; n < 2; ++n) acc[a][b][m][n] = (f32x4){0.f, 0.f, 0.f, 0.f};
        cur = nxt; cA = nA; cB = nB; ++ui;
        if (wr == 1) PG8_BAR;
    }
    PG8_WAIT_V(0);
    PG8_BAR;
#undef PG8_SA
#undef PG8_SB
#undef PG8_STAGE
#undef PG8_LDA
#undef PG8_LDB
#undef PG8_MMA
#undef PG8_WAIT_V
#undef PG8_WAIT_L
#undef PG8_BAR
#undef PG8_SCHED
}

typedef f32x4 Acc[2][2][4][2];
struct EpiStore {
    bf16_t* O; unsigned ldc;
    DI void operator()(const Acc& acc, const Unit& u, int wr, int wc, int fr, int fq) const {
        asm volatile("" : "+v"(fr), "+v"(fq));
        const int row0 = u.pm * BM + wr * 64 + fr, col0 = u.pn * BM + wc * 32 + 8 * fq;
#pragma unroll
        for (int ai = 0; ai < 2; ++ai)
#pragma unroll
            for (int m = 0; m < 4; ++m) { bf16_t* rowp = O + (size_t)(row0 + ai * HALF + m * 16) * ldc + col0;
#pragma unroll
                for (int bj = 0; bj < 2; ++bj) { const f32x4 v0 = acc[ai][bj][m][0], v1 = acc[ai][bj][m][1];
                    u32x4 w; w.x = cvt_pk_bf16(v0[0], v0[1]); w.y = cvt_pk_bf16(v0[2], v0[3]); w.z = cvt_pk_bf16(v1[0], v1[1]); w.w = cvt_pk_bf16(v1[2], v1[3]);
                    *(u32x4*)(rowp + bj * HALF) = w; } }
    }
};
struct EpiSwiglu {
    bf16_t* O;
    DI void operator()(const Acc& acc, const Unit& u, int wr, int wc, int fr, int fq) const {
        asm volatile("" : "+v"(fr), "+v"(fq));
        const int row0 = u.pm * BM + wr * 64 + fr, col0 = u.pn * HALF + wc * 32 + 8 * fq;
#pragma unroll
        for (int ai = 0; ai < 2; ++ai)
#pragma unroll
            for (int m = 0; m < 4; ++m) { bf16_t* rowp = O + (size_t)(row0 + ai * HALF + m * 16) * FF + col0;
                float r[8];
#pragma unroll
                for (int n = 0; n < 2; ++n)
#pragma unroll
                    for (int j = 0; j < 4; ++j) { const float gv = acc[ai][0][m][n][j], uv = acc[ai][1][m][n][j]; r[n * 4 + j] = gv * __builtin_amdgcn_rcpf(1.f + __expf(-gv)) * uv; }
                u32x4 w; w.x = cvt_pk_bf16(r[0], r[1]); w.y = cvt_pk_bf16(r[2], r[3]); w.z = cvt_pk_bf16(r[4], r[5]); w.w = cvt_pk_bf16(r[6], r[7]);
                *(u32x4*)rowp = w; }
    }
};
template <bool IN32> DI f32x4 ld_h(const void* base, size_t off) {
    if constexpr (IN32) return *(const f32x4*)((const float*)base + off);
    else { const u32x2 w = *(const u32x2*)((const bf16_t*)base + off); return (f32x4){bflo(w.x), bfhi(w.x), bflo(w.y), bfhi(w.y)}; } }
template <bool OUT32> DI void st_h(void* base, size_t off, const f32x4 v) {
    if constexpr (OUT32) *(f32x4*)((float*)base + off) = v;
    else { u32x2 w; w.x = cvt_pk_bf16(v[0], v[1]); w.y = cvt_pk_bf16(v[2], v[3]); *(u32x2*)((bf16_t*)base + off) = w; } }
template <bool IN32, bool OUT32> struct EpiResid {
    const void* hin0; const void* hin1; void* hout; const float* gate; float coef;
    DI void operator()(const Acc& acc, const Unit& u, int wr, int wc, int fr, int fq) const {
        asm volatile("" : "+v"(fr), "+v"(fq));
        const int trow = u.pm * BM; const int cond = trow < T_CTX ? 0 : 1 + ((trow - T_CTX) >> 12);
        const size_t isz = IN32 ? 4 : 2, osz = OUT32 ? 4 : 2;
        const char* hin = trow < T_CTX ? (const char*)hin0 + (size_t)trow * DM * isz : (const char*)hin1 + (size_t)(trow - T_CTX) * DM * isz;
        char* ho = (char*)hout + (size_t)trow * DM * osz;
        const int r0 = wr * 64 + fr, col0 = u.pn * BM + wc * 32 + 4 * fq;
        const float* gp = gate + (size_t)cond * (NMOD * DM) + col0;
        f32x4 gv[2][2];
#pragma unroll
        for (int bj = 0; bj < 2; ++bj)
#pragma unroll
            for (int n = 0; n < 2; ++n) gv[bj][n] = *(const f32x4*)(gp + bj * HALF + n * 16) * coef;
#pragma unroll
        for (int ai = 0; ai < 2; ++ai)
#pragma unroll
            for (int m = 0; m < 4; ++m) { const size_t off = (size_t)(r0 + ai * HALF + m * 16) * DM + col0;
#pragma unroll
                for (int bj = 0; bj < 2; ++bj)
#pragma unroll
                    for (int n = 0; n < 2; ++n) { const f32x4 hv = ld_h<IN32>(hin, off + bj * HALF + n * 16);
                        st_h<OUT32>(ho, off + bj * HALF + n * 16, hv + gv[bj][n] * acc[ai][bj][m][n]); }
                asm volatile("" ::: "memory"); }
    }
};
typedef f32x4 AccH[2][1][4][2];
template <bool IN32, bool OUT32> struct EpiResidHN {
    const void* hin0; const void* hin1; void* hout; const float* gate; float coef;
    DI void operator()(const AccH& acc, const Unit& u, int wr, int wc, int fr, int fq) const {
        asm volatile("" : "+v"(fr), "+v"(fq));
        const int trow = u.pm * BM; const int cond = trow < T_CTX ? 0 : 1 + ((trow - T_CTX) >> 12);
        const size_t isz = IN32 ? 4 : 2, osz = OUT32 ? 4 : 2;
        const char* hin = trow < T_CTX ? (const char*)hin0 + (size_t)trow * DM * isz : (const char*)hin1 + (size_t)(trow - T_CTX) * DM * isz;
        char* ho = (char*)hout + (size_t)trow * DM * osz;
        const int r0 = wr * 64 + fr, col0 = u.pn * HALF + wc * 32 + 4 * fq;
        const float* gp = gate + (size_t)cond * (NMOD * DM) + col0;
        f32x4 gv[2];
#pragma unroll
        for (int n = 0; n < 2; ++n) gv[n] = *(const f32x4*)(gp + n * 16) * coef;
#pragma unroll
        for (int ai = 0; ai < 2; ++ai)
#pragma unroll
            for (int m = 0; m < 4; ++m) { const size_t off = (size_t)(r0 + ai * HALF + m * 16) * DM + col0;
#pragma unroll
                for (int n = 0; n < 2; ++n) { const f32x4 hv = ld_h<IN32>(hin, off + n * 16);
                    st_h<OUT32>(ho, off + n * 16, hv + gv[n] * acc[ai][0][m][n]); }
                asm volatile("" ::: "memory"); }
    }
};
struct EpiStoreHN {
    bf16_t* O0; unsigned ldc0; ptrdiff_t dO1; unsigned ldc1;
    DI void operator()(const AccH& acc, const Unit& u, int wr, int wc, int fr, int fq) const {
        asm volatile("" : "+v"(fr), "+v"(fq));
        const bool second = u.pn >= 256;
        bf16_t* O = (bf16_t*)((char*)O0 + (second ? dO1 : (ptrdiff_t)0)); const unsigned ldc = second ? ldc1 : ldc0;
        const int row0 = u.pm * BM + wr * 64 + fr, col0 = u.pn * HALF + wc * 32 + 8 * fq;
#pragma unroll
        for (int ai = 0; ai < 2; ++ai)
#pragma unroll
            for (int m = 0; m < 4; ++m) { bf16_t* rowp = O + (size_t)(row0 + ai * HALF + m * 16) * ldc + col0;
                const f32x4 v0 = acc[ai][0][m][0], v1 = acc[ai][0][m][1];
                u32x4 w; w.x = cvt_pk_bf16(v0[0], v0[1]); w.y = cvt_pk_bf16(v0[2], v0[3]); w.z = cvt_pk_bf16(v1[0], v1[1]); w.w = cvt_pk_bf16(v1[2], v1[3]);
                *(u32x4*)rowp = w; }
    }
};
struct SchedWinTail {
    const char* XN; const char* WIN; const char* WINF; int G, c;
    DI bool next(int i, Unit& u) const { const int L = i * G + c; if (L >= 198) return false;
        if (L < 70) { u.pm = 153 + L / 10; u.pn = L % 10; u.A = XN + (size_t)u.pm * BM * (DM * 2); u.B = WIN + (size_t)u.pn * HALF * (DM * 2); }
        else { const int t = L - 70; u.pm = t & 1; u.pn = 256 + (t >> 1); u.A = WINF + (size_t)u.pm * BM * (DM * 2); u.B = XN + (size_t)u.pn * HALF * (DM * 2); }
        return true; }
};
struct SchedHN {
    const char* A; const char* B; unsigned lda, ldb; int G, c;
    DI bool next(int i, Unit& u) const { const int L = i * G + c; if (L >= 256) return false; const int xcd = L & 7, slot = L >> 3;
        u.pm = 128 + xcd * 4 + (slot >> 3); u.pn = slot & 7;
        u.A = A + (size_t)u.pm * BM * lda; u.B = B + (size_t)u.pn * HALF * ldb; return true; }
};
struct EpiGlu {
    const bf16_t* YS; const float* bias; bf16_t* O;
    DI void operator()(const Acc& acc, const Unit& u, int wr, int wc, int fr, int fq) const {
        asm volatile("" : "+v"(fr), "+v"(fq));
        const int row0 = u.pm * BM + wr * 64 + fr, col0 = wc * 32 + 8 * fq;
#pragma unroll
        for (int ai = 0; ai < 2; ++ai)
#pragma unroll
            for (int m = 0; m < 4; ++m) { const int row = row0 + ai * HALF + m * 16;
#pragma unroll
                for (int bj = 0; bj < 2; ++bj) {
                    const f32x4 b0 = *(const f32x4*)(bias + col0 + bj * HALF), b1 = *(const f32x4*)(bias + col0 + bj * HALF + 4);
                    const u32x4 yv = *(const u32x4*)(YS + (size_t)row * 256 + col0 + bj * HALF);
                    const f32x4 v0 = acc[ai][bj][m][0] + b0, v1 = acc[ai][bj][m][1] + b1;
                    u32x4 w;
                    w.x = cvt_pk_bf16(bflo(yv.x) * sigmoid_f(v0[0]), bfhi(yv.x) * sigmoid_f(v0[1])); w.y = cvt_pk_bf16(bflo(yv.y) * sigmoid_f(v0[2]), bfhi(yv.y) * sigmoid_f(v0[3]));
                    w.z = cvt_pk_bf16(bflo(yv.z) * sigmoid_f(v1[0]), bfhi(yv.z) * sigmoid_f(v1[1])); w.w = cvt_pk_bf16(bflo(yv.w) * sigmoid_f(v1[2]), bfhi(yv.w) * sigmoid_f(v1[3]));
                    *(u32x4*)(O + (size_t)row * DM + col0 + bj * HALF) = w;
                    asm volatile("" ::: "memory"); } }
    }
};
struct EpiBias {
    const float* bias; bf16_t* O; int cbase;
    DI void operator()(const Acc& acc, const Unit& u, int wr, int wc, int fr, int fq) const {
        asm volatile("" : "+v"(fr), "+v"(fq));
        const int row0 = u.pm * BM + wr * 64 + fr, col0 = wc * 32 + 8 * fq;
#pragma unroll
        for (int ai = 0; ai < 2; ++ai)
#pragma unroll
            for (int m = 0; m < 4; ++m) { const int row = row0 + ai * HALF + m * 16;
#pragma unroll
                for (int bj = 0; bj < 2; ++bj) {
                    const f32x4 b0 = *(const f32x4*)(bias + col0 + bj * HALF), b1 = *(const f32x4*)(bias + col0 + bj * HALF + 4);
                    const f32x4 v0 = acc[ai][bj][m][0] + b0, v1 = acc[ai][bj][m][1] + b1;
                    u32x4 w; w.x = cvt_pk_bf16(v0[0], v0[1]); w.y = cvt_pk_bf16(v0[2], v0[3]); w.z = cvt_pk_bf16(v1[0], v1[1]); w.w = cvt_pk_bf16(v1[2], v1[3]);
                    *(u32x4*)(O + (size_t)row * DM + cbase + col0 + bj * HALF) = w;
                    asm volatile("" ::: "memory"); } }
    }
};
struct SchedDftLat {
    const char* TC; size_t dT; const char* PQT; int G, c;
    DI bool next(int i, Unit& u) const { const int L = i * G + c; if (L >= 256) return false; const int part = L & 3, mt = (L >> 2) & 7, b = L >> 5, cs = part >> 1, kh = part & 1;
        u.A = TC + (size_t)cs * dT + (size_t)(1 + 256 * mt) * 8192 + (size_t)kh * 4096; u.B = PQT + (size_t)cs * 256 * (T_ALL * 2) + (size_t)(T_CTX + b * 4096 + kh * 2048) * 2;
        u.pm = b * 8 + mt; u.pn = part; return true; }
};
struct SchedDftCtx {
    const char* TC; size_t dT; const char* PQT; int G, c;
    DI bool next(int i, Unit& u) const { const int L = i * G + (c + G / 4) % G; if (L >= 64) return false; const int half = L & 1, b = L >> 1;
        u.A = TC + (size_t)half * dT; u.B = PQT + (size_t)half * 256 * (T_ALL * 2) + (size_t)(b * 256) * 2;
        u.pm = b; u.pn = half; return true; }
};
struct EpiDftSym {
    bf16_t* O;
    DI void operator()(const Acc& acc, const Unit& u, int wr, int wc, int fr, int fq) const {
        asm volatile("" : "+v"(fr), "+v"(fq));
        const int b = u.pm >> 3, mt = u.pm & 7, part = u.pn; const unsigned sgn = (part >> 1) ? 0x80008000u : 0u;
        bf16_t* base = O + (size_t)(T_CTX + b * 4096) * 1024 + part * 256 + wc * 32 + 8 * fq;
        const int lp0 = 1 + 256 * mt + wr * 64 + fr;
#pragma unroll
        for (int ai = 0; ai < 2; ++ai)
#pragma unroll
            for (int m = 0; m < 4; ++m) { const int lp = lp0 + ai * HALF + m * 16;
#pragma unroll
                for (int bj = 0; bj < 2; ++bj) { const f32x4 v0 = acc[ai][bj][m][0], v1 = acc[ai][bj][m][1];
                    u32x4 w; w.x = cvt_pk_bf16(v0[0], v0[1]); w.y = cvt_pk_bf16(v0[2], v0[3]); w.z = cvt_pk_bf16(v1[0], v1[1]); w.w = cvt_pk_bf16(v1[2], v1[3]);
                    *(u32x4*)(base + (unsigned)(lp * 1024 + bj * HALF)) = w;
                    w.x ^= sgn; w.y ^= sgn; w.z ^= sgn; w.w ^= sgn;
                    *(u32x4*)(base + (unsigned)((4096 - lp) * 1024 + bj * HALF)) = w;
                    asm volatile("" ::: "memory"); } }
    }
};
struct EpiDftCtx {
    bf16_t* O;
    DI void operator()(const Acc& acc, const Unit& u, int wr, int wc, int fr, int fq) const {
        asm volatile("" : "+v"(fr), "+v"(fq));
        const int row0 = u.pm * BM + wr * 64 + fr, col0 = u.pn * 512 + wc * 32 + 8 * fq;
#pragma unroll
        for (int ai = 0; ai < 2; ++ai)
#pragma unroll
            for (int m = 0; m < 4; ++m) { bf16_t* rowp = O + (size_t)(row0 + ai * HALF + m * 16) * 1024 + col0;
#pragma unroll
                for (int bj = 0; bj < 2; ++bj) { const f32x4 v0 = acc[ai][bj][m][0], v1 = acc[ai][bj][m][1];
                    u32x4 w; w.x = cvt_pk_bf16(v0[0], v0[1]); w.y = cvt_pk_bf16(v0[2], v0[3]); w.z = cvt_pk_bf16(v1[0], v1[1]); w.w = cvt_pk_bf16(v1[2], v1[3]);
                    *(u32x4*)(rowp + bj * HALF) = w; *(u32x4*)(rowp + 256 + bj * HALF) = (u32x4){0u, 0u, 0u, 0u}; } }
    }
};
}

constexpr int PTAB_OFF = 131072;
struct InTab { const unsigned char* lds;
    DI const float* operator[](int k) const { const u32x2 v = *(const u32x2*)(lds + PTAB_OFF + 8 * k);
        const unsigned long long p = ((unsigned long long)(unsigned)__builtin_amdgcn_readfirstlane((int)v.y) << 32) | (unsigned)__builtin_amdgcn_readfirstlane((int)v.x); return (const float*)(const __attribute__((address_space(1))) float*)p; } };
struct Frame {
    unsigned char* lds; LAS unsigned char* ldsl;
    int tid, lane, wave, G, bid;
    InTab in; float* out; unsigned char* ws;
};
DI Frame mkframe(unsigned char* lds, int wv) {
    Frame F; F.lds = lds; F.ldsl = (LAS unsigned char*)lds;
    asm volatile("" : "+s"(wv));
    unsigned z = 0u; asm volatile("v_mov_b32 %0, 0" : "=v"(z));
    int tid = wv * 64 + (int)__builtin_amdgcn_mbcnt_hi(~0u, __builtin_amdgcn_mbcnt_lo(~0u, z)); asm volatile("" : "+v"(tid));
    F.tid = tid; F.lane = tid & 63; F.wave = __builtin_amdgcn_readfirstlane(tid >> 6);
    int g = gridDim.x, b = blockIdx.x; asm volatile("" : "+s"(g), "+s"(b)); F.G = g; F.bid = b;
    F.in.lds = lds; F.out = (float*)F.in[36]; F.ws = (unsigned char*)F.in[37];
    return F;
}


#define XB_TMO      128
#define XB_XCNT(j)  (256  + 64 * (j))
#define XB_XSUB(j)  (1280 + 64 * (j))
#define XB_XGEN(j)  (2304 + 64 * (j))
#define XB_TOP      3328
#define XB_TOPGEN   3392
#define XB_SPIN_CAP (1u << 20)
constexpr int XBST_OFF = PTAB_OFF + 512;
DI unsigned xb_ld(unsigned* p)              { return __hip_atomic_load(p, __ATOMIC_RELAXED, __HIP_MEMORY_SCOPE_AGENT); }
DI unsigned xb_add(unsigned* p, unsigned v) { return __hip_atomic_fetch_add(p, v, __ATOMIC_RELAXED, __HIP_MEMORY_SCOPE_AGENT); }
DI unsigned xb_xcc_id() { return (unsigned)__builtin_amdgcn_s_getreg((3 << 11) | 20) & 0xFu; }
#define XB_SPIN(cond, bar) do { unsigned _sp = 0; while (cond) { __builtin_amdgcn_s_sleep(1); \
    if ((++_sp & 255u) == 0u) { if (xb_ld(&(bar)[XB_TMO])) break; if (_sp > XB_SPIN_CAP) { atomicAdd(&(bar)[XB_TMO], 1u); break; } } } } while (0)
DI void xcd_barrier_complete(unsigned* bar, unsigned x, unsigned& nloc, unsigned& nx) {
    const unsigned G = gridDim.x;
    unsigned sum, cnt, mine, sp = 0u;
    for (;;) {
        sum = 0u; cnt = 0u; mine = 0u;
#pragma unroll
        for (unsigned j = 0; j < 16; ++j) { const unsigned c = xb_ld(&bar[XB_XCNT(j)]); sum += c; cnt += (c > 0u) ? 1u : 0u; mine = (j == x) ? c : mine; }
        if (sum == G) break;
        __builtin_amdgcn_s_sleep(1);
        if ((++sp & 255u) == 0u) { if (xb_ld(&bar[XB_TMO])) break; if (sp > XB_SPIN_CAP) { atomicAdd(&bar[XB_TMO], 1u); break; } }
    }
    nloc = mine > 0u ? mine : 1u; nx = cnt > 0u ? cnt : 1u;
}
DI void xcd_sync(unsigned char* lds, int wv) {
    asm volatile("s_waitcnt vmcnt(0) lgkmcnt(0)" ::: "memory");
    __syncthreads();
    asm volatile("" : "+s"(wv));
    if (wv == 0) {
        unsigned z = 0u; asm volatile("v_mov_b32 %0, 0" : "=v"(z));
        const unsigned lane = __builtin_amdgcn_mbcnt_hi(~0u, __builtin_amdgcn_mbcnt_lo(~0u, z));
        if (lane == 0) {
            InTab in; in.lds = lds; unsigned* bar = (unsigned*)((unsigned char*)in[37] + OFF_CTL);
            volatile unsigned* st = (volatile unsigned*)(lds + XBST_OFF);
            const unsigned x = xb_xcc_id();
            __builtin_amdgcn_s_waitcnt(0);
            unsigned nloc = st[0], nx = st[1];
            if (nloc == 0u) { xcd_barrier_complete(bar, x, nloc, nx); st[0] = nloc; st[1] = nx; }
            const unsigned old = xb_add(&bar[XB_XSUB(x)], 1u);
            const unsigned gen = old / nloc;
            if (old + 1u == (gen + 1u) * nloc) {
                __builtin_amdgcn_fence(__ATOMIC_RELEASE, "agent");
                asm volatile("s_waitcnt vmcnt(0)" ::: "memory");
                const unsigned og = xb_add(&bar[XB_TOP], 1u);
                const unsigned tg = og / nx;
                if (og + 1u == (tg + 1u) * nx) xb_add(&bar[XB_TOPGEN], 1u);
                else XB_SPIN(xb_ld(&bar[XB_TOPGEN]) == tg, bar);
                __builtin_amdgcn_fence(__ATOMIC_ACQUIRE, "agent");
                xb_add(&bar[XB_XGEN(x)], 1u);
                asm volatile("s_waitcnt vmcnt(0)" ::: "memory");
            } else {
                XB_SPIN(xb_ld(&bar[XB_XGEN(x)]) == gen, bar);
                __builtin_amdgcn_fence(__ATOMIC_ACQUIRE, "agent");
                asm volatile("s_waitcnt vmcnt(0)" ::: "memory");
            }
        }
    }
    __syncthreads();
}

DI void transpose_item(const float* W, int ldw, int k0, int n0, bf16_t* WT, int ldt, int drow0, int dk0, int dk1, float* scr, int lane) {
    { float tv[32];
#pragma unroll
      for (int i = 0; i < 32; ++i) tv[i] = W[(size_t)(k0 + 2 * i + (lane >> 5)) * ldw + n0 + (lane & 31)];
#pragma unroll
      for (int i = 0; i < 32; ++i) scr[(2 * i + (lane >> 5)) * 33 + (lane & 31)] = tv[i]; }
    asm volatile("" ::: "memory"); __builtin_amdgcn_wave_barrier(); asm volatile("" ::: "memory"); asm volatile("s_waitcnt lgkmcnt(0)" ::: "memory");
    const int c = lane & 7;
#pragma unroll
    for (int j = 0; j < 4; ++j) { const int n = (lane >> 3) + 8 * j; const float* s = scr + (8 * c) * 33 + n;
        u32x4 o; o.x = cvt_pk_bf16(s[0 * 33], s[1 * 33]); o.y = cvt_pk_bf16(s[2 * 33], s[3 * 33]); o.z = cvt_pk_bf16(s[4 * 33], s[5 * 33]); o.w = cvt_pk_bf16(s[6 * 33], s[7 * 33]);
        *(u32x4*)(WT + (size_t)(drow0 + n) * ldt + dk0 + 8 * c) = o;
        if (dk1 >= 0) *(u32x4*)(WT + (size_t)(drow0 + n) * ldt + dk1 + 8 * c) = o; }
    asm volatile("" ::: "memory"); __builtin_amdgcn_wave_barrier(); asm volatile("" ::: "memory"); asm volatile("s_waitcnt lgkmcnt(0)" ::: "memory");
}

DI void p0_phase(unsigned char* lds_, int wv_) {
    Frame F = mkframe(lds_, wv_);
    const int gw = F.bid * NWAVES + F.wave, NGW = F.G * NWAVES;
    {
        float* scr = (float*)(F.lds + F.wave * 8704);
        constexpr int PER_L = 6 * 1408 + 640 + 512 + 32 + 32;
        for (int it = gw; it < 2 * PER_L; it += NGW) {
            const int l = it / PER_L; int r = it % PER_L;
            if (r < 6 * 1408) { const int j = r / 1408, q = r % 1408, f = j / 3, t = j % 3;
                const float* W = F.in[12 + j] + (size_t)l * DM * FF;
                if (t < 2) { const int kb = q / 88, nb = q % 88, n0 = 32 * nb;
                    transpose_item(W, FF, 64 * kb, n0, (bf16_t*)(F.ws + OFF_WGU + (size_t)(l * 2 + f) * SZ_WGU), DM, (n0 >> 7) * 256 + (n0 & 127) + (t ? 128 : 0), 64 * kb, -1, scr, F.lane); }
                else { const int kb = q / 32, nb = q % 32;
                    transpose_item(W, DM, 64 * kb, 32 * nb, (bf16_t*)(F.ws + OFF_WDN + (size_t)(l * 2 + f) * SZ_WDN), FF, 32 * nb, 64 * kb, -1, scr, F.lane); }
                continue; }
            r -= 6 * 1408;
            if (r < 640) { const int kb = r / 40, nb = r % 40;
                transpose_item(F.in[18] + (size_t)l * DM * 1536, 1536, 64 * kb, 32 * nb, (bf16_t*)(F.ws + OFF_WIN + (size_t)l * NPROJ * DM * 2), DM, 32 * nb, 64 * kb, -1, scr, F.lane); continue; }
            r -= 640;
            if (r < 512) { const int kb = r / 32, nb = r % 32;
                transpose_item(F.in[19] + (size_t)l * DM * DM, DM, 64 * kb, 32 * nb, (bf16_t*)(F.ws + OFF_WOUT + (size_t)l * DM * DM * 2), DM, 32 * nb, 64 * kb, -1, scr, F.lane); continue; }
            r -= 512;
            if (r < 32) { const int kb = r / 8, nb = r % 8;
                transpose_item(F.in[28] + (size_t)l * 65536, 256, 64 * kb, 32 * nb, (bf16_t*)(F.ws + OFF_WGLU + (size_t)l * 65536 * 2), 256, 32 * nb, 64 * kb, -1, scr, F.lane); continue; }
            r -= 32;
            { const int kb = r / 8, nb = r % 8;
                transpose_item(F.in[33] + (size_t)l * 65536, 256, 64 * kb, 32 * nb, (bf16_t*)(F.ws + OFF_WFN + (size_t)l * 256 * 1024 * 2), 1024, 32 * nb, 64 * kb, 64 * kb + 256, scr, F.lane);
                transpose_item(F.in[33] + (size_t)l * 65536, 256, 64 * kb, 32 * nb, (bf16_t*)(F.ws + OFF_WFN + (size_t)l * 256 * 1024 * 2), 1024, 32 * nb, 64 * kb + 512, 64 * kb + 768, scr, F.lane); }
        }
    }
    __syncthreads();
    float* tab = (float*)(F.lds);
    for (int j = F.tid; j < 4096; j += NTHREADS) tab[j] = cospif((float)j * (1.0f / 2048.0f));
    __syncthreads();
    {
        bf16_t* TC4 = (bf16_t*)(F.ws + OFF_TC4); bf16_t* TS4 = (bf16_t*)(F.ws + OFF_TS4);
        for (int rr = F.bid; rr < 2049; rr += F.G) {
            const int l0 = 8 * F.tid; float cv[8], sv[8];
#pragma unroll
            for (int j = 0; j < 8; ++j) { const int idx = (rr * (l0 + j)) & 4095; cv[j] = tab[idx] * (1.f / 64.f); sv[j] = -tab[(idx - 1024) & 4095] * (1.f / 64.f); }
            u32x4 a, b; a.x = cvt_pk_bf16(cv[0], cv[1]); a.y = cvt_pk_bf16(cv[2], cv[3]); a.z = cvt_pk_bf16(cv[4], cv[5]); a.w = cvt_pk_bf16(cv[6], cv[7]);
            b.x = cvt_pk_bf16(sv[0], sv[1]); b.y = cvt_pk_bf16(sv[2], sv[3]); b.z = cvt_pk_bf16(sv[4], sv[5]); b.w = cvt_pk_bf16(sv[6], sv[7]);
            *(u32x4*)(TC4 + (size_t)rr * 4096 + l0) = a; *(u32x4*)(TS4 + (size_t)rr * 4096 + l0) = b;
        }
        bf16_t* TC2 = (bf16_t*)(F.ws + OFF_TC2); bf16_t* TS2 = (bf16_t*)(F.ws + OFF_TS2);
        for (int rr = F.bid; rr < 256; rr += F.G) if (F.tid < 32) {
            const int l0 = 8 * F.tid; float cv[8], sv[8];
#pragma unroll
            for (int j = 0; j < 8; ++j) { const int idx = ((rr * (l0 + j)) & 255) * 16; cv[j] = tab[idx] * (1.f / 16.f); sv[j] = -tab[(idx - 1024) & 4095] * (1.f / 16.f); }
            u32x4 a, b; a.x = cvt_pk_bf16(cv[0], cv[1]); a.y = cvt_pk_bf16(cv[2], cv[3]); a.z = cvt_pk_bf16(cv[4], cv[5]); a.w = cvt_pk_bf16(cv[6], cv[7]);
            b.x = cvt_pk_bf16(sv[0], sv[1]); b.y = cvt_pk_bf16(sv[2], sv[3]); b.z = cvt_pk_bf16(sv[4], sv[5]); b.w = cvt_pk_bf16(sv[6], sv[7]);
            *(u32x4*)(TC2 + (size_t)rr * 256 + l0) = a; *(u32x4*)(TS2 + (size_t)rr * 256 + l0) = b;
        }
    }
    {
        float* wrow = (float*)(F.lds + 16384);
        for (int u = F.bid; u < 256; u += F.G) {
            const int l = u >> 7, k0 = 8 * (u & 127);
            __syncthreads();
            for (int e = F.tid; e < 2048; e += NTHREADS) wrow[e] = F.in[18][(size_t)l * DM * 1536 + (size_t)(k0 + (e >> 8)) * 1536 + 1280 + (e & 255)];
            __syncthreads();
            const int n2 = F.tid, nn = n2 & 255, sh = (n2 >= 256) ? 1024 : 0;
            float a[8] = {0.f, 0.f, 0.f, 0.f, 0.f, 0.f, 0.f, 0.f};
            for (int c = 0; c < 256; ++c) { const float t = tab[((((c * nn) & 255) << 4) - sh) & 4095];
#pragma unroll
                for (int r = 0; r < 8; ++r) a[r] += wrow[r * 256 + c] * t; }
            u32x4 o; o.x = cvt_pk_bf16(a[0] * 0.0625f, a[1] * 0.0625f); o.y = cvt_pk_bf16(a[2] * 0.0625f, a[3] * 0.0625f); o.z = cvt_pk_bf16(a[4] * 0.0625f, a[5] * 0.0625f); o.w = cvt_pk_bf16(a[6] * 0.0625f, a[7] * 0.0625f);
            *(u32x4*)((bf16_t*)(F.ws + OFF_WINF) + (size_t)l * 512 * DM + (size_t)n2 * DM + k0) = o;
        }
    }
    __syncthreads();
    {
        float* sc = (float*)(F.lds);
        float* red = (float*)(F.lds + 40960);
        for (int e = F.tid; e < 9 * 1024; e += NTHREADS) { const int i = e >> 10, k = e & 1023; const float v = (i == 0) ? F.in[6][k] : F.in[5][(size_t)(i - 1) * DM + k]; sc[e] = silu_f(v); }
        __syncthreads();
        for (int u = F.bid; u < 288; u += F.G) {
            const int l = u / 144, j0 = 64 * (u % 144), jc = F.tid & 63, kg = F.tid >> 6;
            const float* W = F.in[7] + (size_t)l * DM * 9216 + j0 + jc;
            float a[9] = {0.f, 0.f, 0.f, 0.f, 0.f, 0.f, 0.f, 0.f, 0.f};
            for (int k0 = kg * 128; k0 < kg * 128 + 128; k0 += 16) { float wv[16];
#pragma unroll
                for (int q = 0; q < 16; ++q) wv[q] = W[(size_t)(k0 + q) * 9216];
#pragma unroll
                for (int q = 0; q < 16; ++q) {
#pragma unroll
                    for (int i = 0; i < 9; ++i) a[i] += sc[i * 1024 + k0 + q] * wv[q]; } }
#pragma unroll
            for (int i = 0; i < 9; ++i) red[(kg * 9 + i) * 64 + jc] = a[i];
            __syncthreads();
            for (int o = F.tid; o < 576; o += NTHREADS) { const int i = o >> 6, jj = o & 63; float s = 0.f;
#pragma unroll
                for (int q = 0; q < 8; ++q) s += red[(q * 9 + i) * 64 + jj];
                ((float*)(F.ws + OFF_MOD))[(size_t)(l * 9 + i) * 9216 + j0 + jj] = s + F.in[8][(size_t)l * 9216 + j0 + jj]; }
            __syncthreads();
        }
    }
    {
        const size_t gt = (size_t)F.bid * NTHREADS + F.tid, GT = (size_t)F.G * NTHREADS;
        for (size_t e = gt; e < (size_t)2 * 2 * 8 * 2 * 4096; e += GT) {
            const int ch = (int)(e & 4095); size_t r = e >> 12; const int kv = r & 1; r >>= 1; const int b = r & 7; r >>= 3; const int g = r & 1; const int l = (int)(r >> 1);
            const float* src = F.in[2 + g] + ((((size_t)b * 2 + l) * 2 + kv) * 32768) + (size_t)ch * 8;
            const f32x4 v0 = *(const f32x4*)src, v1 = *(const f32x4*)(src + 4);
            u32x4 o; o.x = cvt_pk_bf16(v0[0], v0[1]); o.y = cvt_pk_bf16(v0[2], v0[3]); o.z = cvt_pk_bf16(v1[0], v1[1]); o.w = cvt_pk_bf16(v1[2], v1[3]);
            *(u32x4*)((bf16_t*)(F.ws + OFF_CKV) + e * 8) = o;
        }
        for (size_t e = gt; e < (size_t)4096 * 32; e += GT) { const int pos = (int)(e >> 5), i = (int)(e & 31), f = i & 15;
            const float inv = powf(10000.0f, -(float)f * (1.0f / 16.0f)); const float ang = (float)(i < 16 ? (pos >> 6) : (pos & 63)) * inv;
            ((f32x2*)(F.ws + OFF_ROPE))[e] = (f32x2){cosf(ang), sinf(ang)}; }
        for (size_t e = (size_t)((F.bid + F.G / 2) % F.G) * NTHREADS + F.tid; e < (size_t)2 * 2 * 16 * 64 * 8; e += GT) {
            const int sb = (int)(e & 7), p = (int)((e >> 3) & 63), g = (int)((e >> 9) & 15), dir = (int)((e >> 13) & 1), l = (int)(e >> 14);
            const int pi = ((l * 2 + dir) * 16 + g) * 64 + p;
            const float lre = F.in[20][pi], lim = F.in[21][pi], dt = __expf(F.in[26][(l * 2 + dir) * 16 + g]);
            const float er = expf(lre * dt); float sn, cs; sincosf(lim * dt, &sn, &cs);
            const float ar = er * cs, ai = er * sn, nr = ar - 1.f, ni = ai, dd = 1.f / (lre * lre + lim * lim);
            const float qr = (nr * lre + ni * lim) * dd, qi = (ni * lre - nr * lim) * dd;
            float br[16], bi[16];
#pragma unroll
            for (int c4 = 0; c4 < 4; ++c4) { const f32x4 r = *(const f32x4*)(F.in[22] + (size_t)pi * 16 + 4 * c4), m = *(const f32x4*)(F.in[23] + (size_t)pi * 16 + 4 * c4);
#pragma unroll
                for (int j = 0; j < 4; ++j) { br[4 * c4 + j] = qr * r[j] - qi * m[j]; bi[4 * c4 + j] = qr * m[j] + qi * r[j]; } }
            bf16_t* wre = (bf16_t*)(F.ws + OFF_W128) + ((size_t)pi * 2) * 2048; bf16_t* wim = wre + 2048;
            for (int s_ = sb * 16; s_ < sb * 16 + 16; ++s_) {
                const float kk = (float)(dir ? s_ : 127 - s_); const float pe = expf(kk * lre * dt); float ps, pc; sincosf(kk * lim * dt, &ps, &pc);
                const float pr = pe * pc, pim = pe * ps;
                u32x4 a0, a1, b0, b1;
                a0.x = cvt_pk_bf16(pr * br[0] - pim * bi[0], pr * br[1] - pim * bi[1]); a0.y = cvt_pk_bf16(pr * br[2] - pim * bi[2], pr * br[3] - pim * bi[3]);
                a0.z = cvt_pk_bf16(pr * br[4] - pim * bi[4], pr * br[5] - pim * bi[5]); a0.w = cvt_pk_bf16(pr * br[6] - pim * bi[6], pr * br[7] - pim * bi[7]);
                a1.x = cvt_pk_bf16(pr * br[8] - pim * bi[8], pr * br[9] - pim * bi[9]); a1.y = cvt_pk_bf16(pr * br[10] - pim * bi[10], pr * br[11] - pim * bi[11]);
                a1.z = cvt_pk_bf16(pr * br[12] - pim * bi[12], pr * br[13] - pim * bi[13]); a1.w = cvt_pk_bf16(pr * br[14] - pim * bi[14], pr * br[15] - pim * bi[15]);
                b0.x = cvt_pk_bf16(pr * bi[0] + pim * br[0], pr * bi[1] + pim * br[1]); b0.y = cvt_pk_bf16(pr * bi[2] + pim * br[2], pr * bi[3] + pim * br[3]);
                b0.z = cvt_pk_bf16(pr * bi[4] + pim * br[4], pr * bi[5] + pim * br[5]); b0.w = cvt_pk_bf16(pr * bi[6] + pim * br[6], pr * bi[7] + pim * br[7]);
                b1.x = cvt_pk_bf16(pr * bi[8] + pim * br[8], pr * bi[9] + pim * br[9]); b1.y = cvt_pk_bf16(pr * bi[10] + pim * br[10], pr * bi[11] + pim * br[11]);
                b1.z = cvt_pk_bf16(pr * bi[12] + pim * br[12], pr * bi[13] + pim * br[13]); b1.w = cvt_pk_bf16(pr * bi[14] + pim * br[14], pr * bi[15] + pim * br[15]);
                *(u32x4*)(wre + 16 * s_) = a0; *(u32x4*)(wre + 16 * s_ + 8) = a1; *(u32x4*)(wim + 16 * s_) = b0; *(u32x4*)(wim + 16 * s_ + 8) = b1;
            }
        }
    }
}

DI void norm_phase(unsigned char* lds_, int wv_, int l, int which, bool first) {
    Frame F = mkframe(lds_, wv_);
    const float* h0 = F.in[0]; const float* h1 = F.in[1]; const bf16_t* HB = (const bf16_t*)(F.ws + OFF_HB);
    const float* gvec = F.in[which == 0 ? 9 : which == 1 ? 10 : 11] + l * DM; const float* modl = (const float*)(F.ws + OFF_MOD) + (size_t)l * 9 * 9216; const int jsh = which * 3, jsc = which * 3 + 1;
    const int gw = F.bid * NWAVES + F.wave, NGW = F.G * NWAVES;
    bf16_t* XN = (bf16_t*)(F.out);
    f32x4 gv[4];
#pragma unroll
    for (int j = 0; j < 4; ++j) gv[j] = *(const f32x4*)(gvec + 4 * F.lane + 256 * j);
    for (int row0 = gw * 4; row0 < T_ALL; row0 += NGW * 4) {
        f32x4 v[4][4]; float s[4];
#pragma unroll
        for (int r = 0; r < 4; ++r) { const int row = row0 + r;
            if (first) { const float* src = row < T_CTX ? h0 + (size_t)row * DM : h1 + (size_t)(row - T_CTX) * DM;
#pragma unroll
                for (int j = 0; j < 4; ++j) v[r][j] = *(const f32x4*)(src + 4 * F.lane + 256 * j); }
            else {
#pragma unroll
                for (int j = 0; j < 4; ++j) { const u32x2 w = *(const u32x2*)(HB + (size_t)row * DM + 4 * F.lane + 256 * j); v[r][j] = (f32x4){bflo(w.x), bfhi(w.x), bflo(w.y), bfhi(w.y)}; } } }
#pragma unroll
        for (int r = 0; r < 4; ++r) { float a = 0.f;
#pragma unroll
            for (int j = 0; j < 4; ++j) a += (v[r][j].x * v[r][j].x + v[r][j].y * v[r][j].y) + (v[r][j].z * v[r][j].z + v[r][j].w * v[r][j].w);
            s[r] = a; }
#pragma unroll
        for (int o = 1; o < 64; o <<= 1) {
#pragma unroll
            for (int r = 0; r < 4; ++r) s[r] += shx(s[r], o, F.lane); }
#pragma unroll
        for (int r = 0; r < 4; ++r) { const int row = row0 + r;
            const int cond = row < T_CTX ? 0 : 1 + ((row - T_CTX) >> 12);
            const float* shp = modl + (size_t)cond * 9216 + jsh * 1024; const float* scp = modl + (size_t)cond * 9216 + jsc * 1024;
            const float rstd = rsqrtf(s[r] * (1.f / DM) + EPSF);
#pragma unroll
            for (int j = 0; j < 4; ++j) { const f32x4 sh = *(const f32x4*)(shp + 4 * F.lane + 256 * j), sc = *(const f32x4*)(scp + 4 * F.lane + 256 * j);
                const f32x4 o = (v[r][j] * rstd * gv[j]) * (sc + 1.f) + sh;
                u32x2 w; w.x = cvt_pk_bf16(o.x, o.y); w.y = cvt_pk_bf16(o.z, o.w);
                *(u32x2*)(XN + (size_t)row * DM + 4 * F.lane + 256 * j) = w; } }
    }
}
DI void final_norm_phase(unsigned char* lds_, int wv_) {
    Frame F = mkframe(lds_, wv_);
    const int gw = F.bid * NWAVES + F.wave, NGW = F.G * NWAVES;
    f32x4 gv[4];
#pragma unroll
    for (int j = 0; j < 4; ++j) gv[j] = *(const f32x4*)(F.in[35] + 4 * F.lane + 256 * j);
    for (int row0 = gw * 4; row0 < T_ALL; row0 += NGW * 4) {
        f32x4 v[4][4]; float s[4];
#pragma unroll
        for (int r = 0; r < 4; ++r) { const float* p = F.out + (size_t)(row0 + r) * DM;
#pragma unroll
            for (int j = 0; j < 4; ++j) v[r][j] = *(const f32x4*)(p + 4 * F.lane + 256 * j); }
#pragma unroll
        for (int r = 0; r < 4; ++r) { float a = 0.f;
#pragma unroll
            for (int j = 0; j < 4; ++j) a += (v[r][j].x * v[r][j].x + v[r][j].y * v[r][j].y) + (v[r][j].z * v[r][j].z + v[r][j].w * v[r][j].w);
            s[r] = a; }
#pragma unroll
        for (int o = 1; o < 64; o <<= 1) {
#pragma unroll
            for (int r = 0; r < 4; ++r) s[r] += shx(s[r], o, F.lane); }
#pragma unroll
        for (int r = 0; r < 4; ++r) { float* p = F.out + (size_t)(row0 + r) * DM; const float rstd = rsqrtf(s[r] * (1.f / DM) + EPSF);
#pragma unroll
            for (int j = 0; j < 4; ++j) *(f32x4*)(p + 4 * F.lane + 256 * j) = v[r][j] * rstd * gv[j]; }
    }
}

DI void kprep_phase(unsigned char* lds_, int wv_, int l) {
    Frame F = mkframe(lds_, wv_);
    const int gw = F.bid * NWAVES + F.wave, NGW = F.G * NWAVES;
    const bf16_t* PROJ = (const bf16_t*)(F.ws + OFF_PROJ); bf16_t* KR = (bf16_t*)(F.ws + OFF_KR);
    const f32x2* ROPE = (const f32x2*)(F.ws + OFF_ROPE);
    const int hk = F.lane >> 5, i = F.lane & 31;
    const float gk0 = F.in[32][l * 64 + i], gk1 = F.in[32][l * 64 + i + 32];
    bf16_t n0 = 0, n1 = 0, n2 = 0, n3 = 0;
    if (gw < T_ALL) { const bf16_t* p0 = PROJ + (size_t)gw * NPROJ; n0 = p0[512 + hk * 64 + i]; n1 = p0[512 + hk * 64 + i + 32]; n2 = p0[1024 + hk * 64 + i]; n3 = p0[1024 + hk * 64 + i + 32]; }
    for (int tok = gw; tok < T_ALL; tok += NGW) {
        const bf16_t* pr = PROJ + (size_t)tok * NPROJ;
        float s1 = bf1(n0), s2 = bf1(n1);
        float a1 = bf1(n2), a2 = bf1(n3);
        if (tok + NGW < T_ALL) { const bf16_t* pn = pr + (size_t)NGW * NPROJ; n0 = pn[512 + hk * 64 + i]; n1 = pn[512 + hk * 64 + i + 32]; n2 = pn[1024 + hk * 64 + i]; n3 = pn[1024 + hk * 64 + i + 32]; }
        float ss = a1 * a1 + a2 * a2;
#pragma unroll
        for (int o = 1; o < 32; o <<= 1) ss += shx(ss, o, F.lane);
        const float rn = rsqrtf(ss * (1.f / 64.f) + EPSF);
        a1 = a1 * rn * gk0; a2 = a2 * rn * gk1;
        if (tok >= T_CTX) {
            const int pos = (tok - T_CTX) & 4095; const f32x2 cs = ROPE[pos * 32 + i];
            const float r1 = s1 * cs.x - s2 * cs.y, r2 = s2 * cs.x + s1 * cs.y; s1 = r1; s2 = r2;
            const float q1 = a1 * cs.x - a2 * cs.y, q2 = a2 * cs.x + a1 * cs.y; a1 = q1; a2 = q2;
        } else {
            const int b = tok >> 8, t = tok & 255;
            float* os = F.out + OUT_SWA + ((((size_t)b * 2 + l) * 2 + 0) * 256 + t) * 128;
            float* oa = F.out + OUT_AX + ((((size_t)b * 2 + l) * 2 + 0) * 256 + t) * 128;
            os[hk * 64 + i] = s1; os[hk * 64 + i + 32] = s2; oa[hk * 64 + i] = a1; oa[hk * 64 + i + 32] = a2;
            const unsigned vs = *(const unsigned*)(pr + 640 + 2 * F.lane), va = *(const unsigned*)(pr + 1152 + 2 * F.lane);
            *(f32x2*)(os + 32768 + 2 * F.lane) = (f32x2){bflo(vs), bfhi(vs)};
            *(f32x2*)(oa + 32768 + 2 * F.lane) = (f32x2){bflo(va), bfhi(va)};
        }
        bf16_t* kr = KR + (size_t)tok * 256;
        kr[hk * 64 + i] = (bf16_t)f2bf(s1); kr[hk * 64 + i + 32] = (bf16_t)f2bf(s2);
        kr[128 + hk * 64 + i] = (bf16_t)f2bf(a1); kr[128 + hk * 64 + i + 32] = (bf16_t)f2bf(a2);
    }
}

constexpr int S5_TC = 128, S5_LDS_PER_WAVE = 13824;
struct S5Dir { f32x2 a, aT; f32x2 b[16]; };
DI void s5_load_dir(Frame& F, int l, int dir, int g, int p, S5Dir& d) {
    const int pi = ((l * 2 + dir) * 16 + g) * 64 + p;
    const float lre = F.in[20][pi], lim = F.in[21][pi], dt = __expf(F.in[26][(l * 2 + dir) * 16 + g]);
    const float er = expf(lre * dt); float sn, cs; sincosf(lim * dt, &sn, &cs);
    const float ar = er * cs, ai = er * sn;
    d.a = (f32x2){ar, ai};
    const float nr = ar - 1.f, ni = ai, dd = 1.f / (lre * lre + lim * lim);
    const float qr = (nr * lre + ni * lim) * dd, qi = (ni * lre - nr * lim) * dd;
    const float* bre = F.in[22] + (size_t)pi * 16; const float* bim = F.in[23] + (size_t)pi * 16;
#pragma unroll
    for (int c4 = 0; c4 < 4; ++c4) { const f32x4 r = *(const f32x4*)(bre + 4 * c4), m = *(const f32x4*)(bim + 4 * c4);
#pragma unroll
        for (int j = 0; j < 4; ++j) d.b[4 * c4 + j] = (f32x2){qr * r[j] - qi * m[j], qr * m[j] + qi * r[j]}; }
    float tr = ar, ti = ai;
#pragma unroll
    for (int q = 0; q < 7; ++q) { const float nr2 = tr * tr - ti * ti, ni2 = 2.f * tr * ti; tr = nr2; ti = ni2; }
    d.aT = (f32x2){tr, ti};
}
template <bool WITH_Y>
DI void s5_group(const u32x2 w, const S5Dir& d, f32x2& st, float* U, unsigned* SB, int lane) {
    *(f32x4*)(U + (lane >> 2) * 16 + 4 * (lane & 3)) = (f32x4){bflo(w.x), bfhi(w.x), bflo(w.y), bfhi(w.y)};
    asm volatile("" ::: "memory"); __builtin_amdgcn_wave_barrier(); asm volatile("" ::: "memory");
    f32x4 n0 = *(const f32x4*)(U), n1 = *(const f32x4*)(U + 4), n2 = *(const f32x4*)(U + 8), n3 = *(const f32x4*)(U + 12);
#pragma unroll 4
    for (int k = 0; k < 16; ++k) {
        const f32x4 u0 = n0, u1 = n1, u2 = n2, u3 = n3;
        { const int kn = (k + 1) & 15;
          n0 = *(const f32x4*)(U + kn * 16); n1 = *(const f32x4*)(U + kn * 16 + 4); n2 = *(const f32x4*)(U + kn * 16 + 8); n3 = *(const f32x4*)(U + kn * 16 + 12); }
        f32x2 x0 = d.b[0] * u0[0], x1 = d.b[4] * u1[0], x2 = d.b[8] * u2[0], x3 = d.b[12] * u3[0];
#pragma unroll
        for (int j = 1; j < 4; ++j) { x0 += d.b[j] * u0[j]; x1 += d.b[4 + j] * u1[j]; x2 += d.b[8 + j] * u2[j]; x3 += d.b[12 + j] * u3[j]; }
        const f32x2 bu = (x0 + x1) + (x2 + x3);
        const f32x2 sw = (f32x2){-st.y, st.x};
        st = (st * d.a.x + bu) + sw * d.a.y;
        if (WITH_Y) SB[k * 68 + lane] = cvt_pk_bf16(st.x, st.y);
    }
    asm volatile("" ::: "memory"); __builtin_amdgcn_wave_barrier(); asm volatile("" ::: "memory");
}
DI u32x2 s5_ldu(const bf16_t* PROJ, int tokbase, int g, int dir, int grp, int lane) {
    const int o = grp * 16 + (lane >> 2); const int pos = dir ? (S5_TC - 1 - o) : o;
    return *(const u32x2*)(PROJ + (size_t)(tokbase + pos) * NPROJ + g * 16 + 4 * (lane & 3));
}
DI void s5_decode(int U, bool& lat, int& b, int& g, int& c, int& NC, int& tokbase, f32x2*& E, Frame& F) {
    if (U < 1024) { lat = false; b = U >> 5; g = (U >> 1) & 15; c = U & 1; NC = 2; tokbase = b * 256 + c * S5_TC; E = (f32x2*)(F.ws + OFF_ESTC) + (size_t)((b * 16 + g) * 2) * 2 * 64; }
    else { const int V = U - 1024; lat = true; b = V >> 9; g = (V >> 5) & 15; c = V & 31; NC = 32; tokbase = T_CTX + b * 4096 + c * S5_TC; E = (f32x2*)(F.ws + OFF_ESTL) + (size_t)((b * 16 + g) * 2) * 32 * 64; }
}
DI void s5_pass1(unsigned char* lds_, int wv_, int l) {
    Frame F = mkframe(lds_, wv_);
    const bf16_t* PROJ = (const bf16_t*)(F.ws + OFF_PROJ);
    const int lane = F.lane, n = lane & 15, kq = lane >> 4;
    const int xcd = F.bid & 7, slot = F.bid >> 3, nslot = (F.G + 7) >> 3;
    for (int t = slot; t < 80; t += nslot) {
        const int gd = 4 * xcd + t / 20, nt = t % 20, dir = gd & 1, g = gd >> 1;
        const bf16_t* A = (const bf16_t*)(F.ws + OFF_W128) + ((size_t)((l * 2 + dir) * 16 + g) * 128 + 16 * F.wave + n) * 2048 + 8 * kq;
        const int chunk = 16 * nt + n;
        const bf16_t* Bp = PROJ + (size_t)(chunk * 128 + (kq >> 1)) * NPROJ + g * 16 + 8 * (kq & 1);
        f32x4 acc = (f32x4){0.f, 0.f, 0.f, 0.f};
#pragma unroll 1
        for (int k0 = 0; k0 < 64; k0 += 16) {
            bf16x8 bf[16], af[16];
#pragma unroll
            for (int q = 0; q < 16; ++q) { bf[q] = *(const bf16x8*)(Bp + (size_t)(k0 + q) * (2 * NPROJ)); af[q] = *(const bf16x8*)(A + 32 * (k0 + q)); }
#pragma unroll
            for (int q = 0; q < 16; ++q) acc = __builtin_amdgcn_mfma_f32_16x16x32_bf16(af[q], bf[q], acc, 0, 0, 0);
        }
        f32x2* E; int NC, c;
        if (chunk < 64) { const int b = chunk >> 1; c = chunk & 1; NC = 2; E = (f32x2*)(F.ws + OFF_ESTC) + (size_t)((b * 16 + g) * 2) * 2 * 64; }
        else { const int v = chunk - 64, b = v >> 5; c = v & 31; NC = 32; E = (f32x2*)(F.ws + OFF_ESTL) + (size_t)((b * 16 + g) * 2) * 32 * 64; }
        const int j = dir ? (NC - 1 - c) : c;
        f32x2* Ej = E + (size_t)(dir * NC + j) * 64 + 8 * F.wave + 2 * kq;
        Ej[0] = (f32x2){acc[0], acc[1]}; Ej[1] = (f32x2){acc[2], acc[3]};
    }
}
typedef short s16x4 __attribute__((ext_vector_type(4)));
DI void s5_pass2(unsigned char* lds_, int wv_, int l) {
    Frame F = mkframe(lds_, wv_);
    const int gw = F.bid * NWAVES + F.wave, NGW = F.G * NWAVES;
    const bf16_t* PROJ = (const bf16_t*)(F.ws + OFF_PROJ); bf16_t* YS = (bf16_t*)(F.ws + OFF_YS);
    unsigned char* wl = F.lds + F.wave * S5_LDS_PER_WAVE;
    unsigned* SB = (unsigned*)(wl + 1024); float* YL = (float*)(wl + 5376);
    const int lane = F.lane, tk = lane & 15, rq = lane >> 4;
    unsigned* qctr = (unsigned*)(F.ws + OFF_CTL) + 3600 + 64 * l;
    (void)gw; (void)NGW;
    for (;;) {
        unsigned Uq = 0u; if (lane == 0) Uq = __hip_atomic_fetch_add(qctr, 1u, __ATOMIC_RELAXED, __HIP_MEMORY_SCOPE_AGENT);
        const int Uraw = __builtin_amdgcn_readfirstlane((int)Uq);
        if (Uraw >= 5120) break;
        const int U = 5119 - Uraw;
        bool lat; int b, g, c, NC, tokbase; f32x2* E; s5_decode(U, lat, b, g, c, NC, tokbase, E, F);
        for (int dir = 0; dir < 2; ++dir) {
            const int j = dir ? (NC - 1 - c) : c;
            f32x2 av, aT;
            { const int pi = ((l * 2 + dir) * 16 + g) * 64 + lane;
              const float lre = F.in[20][pi], lim = F.in[21][pi], dt = __expf(F.in[26][(l * 2 + dir) * 16 + g]);
              const float er = expf(lre * dt); float sn, cs; sincosf(lim * dt, &sn, &cs); av = (f32x2){er * cs, er * sn};
              float tr = av.x, ti = av.y;
#pragma unroll
              for (int q = 0; q < 7; ++q) { const float nr2 = tr * tr - ti * ti, ni2 = 2.f * tr * ti; tr = nr2; ti = ni2; }
              aT = (f32x2){tr, ti}; }
            bf16x8 cf[4];
            { const float* cre = F.in[24] + ((size_t)((l * 2 + dir) * 16 + g) * 16 + tk) * 64; const float* cim = F.in[25] + ((size_t)((l * 2 + dir) * 16 + g) * 16 + tk) * 64;
#pragma unroll
              for (int ks = 0; ks < 4; ++ks) { const f32x4 r = *(const f32x4*)(cre + 16 * ks + 4 * rq), m = *(const f32x4*)(cim + 16 * ks + 4 * rq);
                  u32x4 w; w.x = cvt_pk_bf16(r[0], -m[0]); w.y = cvt_pk_bf16(r[1], -m[1]); w.z = cvt_pk_bf16(r[2], -m[2]); w.w = cvt_pk_bf16(r[3], -m[3]);
                  cf[ks] = __builtin_bit_cast(bf16x8, w); } }
            s16x4 bA[8];
            { const bf16_t* wb = (const bf16_t*)(F.ws + OFF_W128) + ((size_t)((l * 2 + dir) * 16 + g) * 128 + tk) * 2048 + (dir ? 0 : 16 * 127) + 4 * rq;
#pragma unroll
              for (int mt = 0; mt < 8; ++mt) bA[mt] = __builtin_bit_cast(s16x4, *(const u32x2*)(wb + (size_t)mt * 16 * 2048)); }
            f32x2 st = (f32x2){0.f, 0.f};
            if (lat) st = *(const f32x2*)(F.in[4] + ((((size_t)b * 2 + l) * 2 + dir) * 16 + g) * 128 + lane * 2);
            auto ldu = [&](int grp) -> u32x2 { const int o = grp * 16 + tk; const int pos = dir ? (S5_TC - 1 - o) : o; return *(const u32x2*)(PROJ + (size_t)(tokbase + pos) * NPROJ + g * 16 + 4 * rq); };
            u32x2 wn = ldu(0);
            const f32x4 dv = *(const f32x4*)(F.in[27] + l * 256 + g * 16 + 4 * rq);
            for (int i0 = 0; i0 < j; i0 += 8) {
                f32x2 e[8];
#pragma unroll
                for (int q = 0; q < 8; ++q) e[q] = (i0 + q < j) ? E[(size_t)(dir * NC + i0 + q) * 64 + lane] : (f32x2){0.f, 0.f};
#pragma unroll
                for (int q = 0; q < 8; ++q) if (i0 + q < j) st = (f32x2){aT.x * st.x - aT.y * st.y + e[q].x, aT.x * st.y + aT.y * st.x + e[q].y};
            }
#pragma unroll 1
            for (int grp = 0; grp < S5_TC / 16; ++grp) {
                const u32x2 w = wn; if (grp + 1 < S5_TC / 16) wn = ldu(grp + 1);
                { const s16x4 ub = __builtin_bit_cast(s16x4, w);
#pragma unroll
                  for (int mt = 0; mt < 8; ++mt) { const f32x4 dd = __builtin_amdgcn_mfma_f32_16x16x16bf16_1k(bA[mt], ub, (f32x4){0.f, 0.f, 0.f, 0.f}, 0, 0, 0);
                      u32x2 pk; pk.x = cvt_pk_bf16_c(dd[0], dd[1]); pk.y = cvt_pk_bf16_c(dd[2], dd[3]); *(u32x2*)(SB + tk * 68 + 8 * mt + 2 * rq) = pk; } }
                asm volatile("" ::: "memory"); __builtin_amdgcn_wave_barrier(); asm volatile("" ::: "memory");
                { unsigned bw[16];
#pragma unroll
                  for (int k = 0; k < 16; ++k) bw[k] = SB[k * 68 + lane];
#pragma unroll
                  for (int k = 0; k < 16; ++k) { const f32x2 bu = (f32x2){bflo(bw[k]), bfhi(bw[k])}; const f32x2 sw = (f32x2){-st.y, st.x};
                      st = (st * av.x + bu) + sw * av.y; SB[k * 68 + lane] = cvt_pk_bf16(st.x, st.y); } }
                asm volatile("" ::: "memory"); __builtin_amdgcn_wave_barrier(); asm volatile("" ::: "memory");
                f32x4 y = (f32x4){0.f, 0.f, 0.f, 0.f};
#pragma unroll
                for (int ks = 0; ks < 4; ++ks) { const bf16x8 sf = *(const bf16x8*)(SB + tk * 68 + ks * 16 + 4 * rq); y = __builtin_amdgcn_mfma_f32_16x16x32_bf16(cf[ks], sf, y, 0, 0, 0); }
                const int o = grp * 16 + tk; const int pos = dir ? (S5_TC - 1 - o) : o;
                if (dir == 0) { *(f32x4*)(YL + pos * 16 + 4 * rq) = y; }
                else {
                    const f32x4 yf = *(const f32x4*)(YL + pos * 16 + 4 * rq);
                    const float y0 = gelu_tanh(y[0] + yf[0] + dv[0] * bflo(w.x)), y1 = gelu_tanh(y[1] + yf[1] + dv[1] * bfhi(w.x));
                    const float y2 = gelu_tanh(y[2] + yf[2] + dv[2] * bflo(w.y)), y3 = gelu_tanh(y[3] + yf[3] + dv[3] * bfhi(w.y));
                    u32x2 ov; ov.x = cvt_pk_bf16(y0, y1); ov.y = cvt_pk_bf16(y2, y3);
                    *(u32x2*)(YS + (size_t)(tokbase + pos) * 256 + g * 16 + 4 * rq) = ov;
                }
                asm volatile("" ::: "memory"); __builtin_amdgcn_wave_barrier(); asm volatile("" ::: "memory");
            }
            if (!lat && j == NC - 1) *(f32x2*)(F.out + OUT_SSM + ((((size_t)b * 2 + l) * 2 + dir) * 16 + g) * 128 + lane * 2) = st;
        }
    }
}

constexpr int AT_ROWB = 144, AT_TILEB = 64 * AT_ROWB, AT_BUFB = 2 * AT_TILEB;
DI int crow(int r, int hi) { return (r & 3) + 8 * (r >> 2) + 4 * hi; }
DI void attn_unit(Frame& F, int l, int g, bool lat, int b, int hk, int qb) {
    const bf16_t* PROJ = (const bf16_t*)(F.ws + OFF_PROJ); const bf16_t* KR = (const bf16_t*)(F.ws + OFF_KR);
    bf16_t* MERGED = (bf16_t*)(F.ws + OFF_MERGED);
    const int lane = F.lane, w = F.wave, r32 = lane & 31, hi = lane >> 5, tid = F.tid;
    const int hq = hk * 2 + (w >> 2), qrow = 32 * (w & 3) + r32, q0 = qb * 128;
    const int seq0 = lat ? T_CTX + b * 4096 : b * 256;
    const int tok = seq0 + q0 + qrow, qpos = q0 + qrow;
    bf16x8 qr[4];
    {
        bf16x8 qn[4];
        const bf16_t* qp = PROJ + (size_t)tok * NPROJ + (g ? 768 : 256) + hq * 64;
        float q[4][8]; float ss = 0.f;
#pragma unroll
        for (int s = 0; s < 4; ++s) { const u32x4 v = *(const u32x4*)(qp + 16 * s + 8 * hi);
            q[s][0] = bflo(v.x); q[s][1] = bfhi(v.x); q[s][2] = bflo(v.y); q[s][3] = bfhi(v.y); q[s][4] = bflo(v.z); q[s][5] = bfhi(v.z); q[s][6] = bflo(v.w); q[s][7] = bfhi(v.w);
#pragma unroll
            for (int j = 0; j < 8; ++j) ss += q[s][j] * q[s][j]; }
        if (g) { ss += shx(ss, 32, lane); const float rn = rsqrtf(ss * (1.f / 64.f) + EPSF);
#pragma unroll
            for (int s = 0; s < 4; ++s) { const f32x4 g0 = *(const f32x4*)(F.in[31] + l * 64 + 16 * s + 8 * hi), g1 = *(const f32x4*)(F.in[31] + l * 64 + 16 * s + 8 * hi + 4);
#pragma unroll
                for (int j = 0; j < 4; ++j) { q[s][j] *= rn * g0[j]; q[s][4 + j] *= rn * g1[j]; } } }
#pragma unroll
        for (int s = 0; s < 4; ++s) { u32x4 wv; wv.x = cvt_pk_bf16(q[s][0] * C2, q[s][1] * C2); wv.y = cvt_pk_bf16(q[s][2] * C2, q[s][3] * C2); wv.z = cvt_pk_bf16(q[s][4] * C2, q[s][5] * C2); wv.w = cvt_pk_bf16(q[s][6] * C2, q[s][7] * C2);
            qn[s] = __builtin_bit_cast(bf16x8, wv); }
        if (lat) {
            const f32x2* rp = (const f32x2*)(F.ws + OFF_ROPE) + (size_t)qpos * 32;
#pragma unroll
            for (int s = 0; s < 2; ++s) { float o1[8], o2[8];
#pragma unroll
                for (int j = 0; j < 8; ++j) { const f32x2 cs = rp[16 * s + 8 * hi + j]; const float x1 = q[s][j], x2 = q[s + 2][j]; o1[j] = (x1 * cs.x - x2 * cs.y) * C2; o2[j] = (x2 * cs.x + x1 * cs.y) * C2; }
                u32x4 w1, w2; w1.x = cvt_pk_bf16(o1[0], o1[1]); w1.y = cvt_pk_bf16(o1[2], o1[3]); w1.z = cvt_pk_bf16(o1[4], o1[5]); w1.w = cvt_pk_bf16(o1[6], o1[7]);
                w2.x = cvt_pk_bf16(o2[0], o2[1]); w2.y = cvt_pk_bf16(o2[2], o2[3]); w2.z = cvt_pk_bf16(o2[4], o2[5]); w2.w = cvt_pk_bf16(o2[6], o2[7]);
                qr[s] = __builtin_bit_cast(bf16x8, w1); qr[s + 2] = __builtin_bit_cast(bf16x8, w2); }
        } else {
#pragma unroll
            for (int s = 0; s < 4; ++s) qr[s] = qn[s];
        }
#pragma unroll
        for (int s = 0; s < 4; ++s) *(bf16x8*)(F.lds + 40960 + w * 4096 + s * 1024 + lane * 16) = qn[s];
    }
    int kstart = 0, nt0, nt1;
    if (!lat) { nt0 = 4; nt1 = 0; }
    else if (g == 0) { kstart = q0 - 128 < 0 ? 0 : q0 - 128; const int ke = q0 + 256 > 4096 ? 4096 : q0 + 256; nt0 = (ke - kstart) >> 6; nt1 = 4; }
    else { nt0 = 64; nt1 = 4; }
    const int NT = nt0 + nt1;
    const bf16_t* K0 = KR + (size_t)(seq0 + kstart) * 256 + g * 128 + hk * 64;
    const bf16_t* V0 = PROJ + (size_t)(seq0 + kstart) * NPROJ + (g ? 1152 : 640) + hk * 64;
    const bf16_t* K1 = (const bf16_t*)(F.ws + OFF_CKV) + ((((size_t)(l * 2 + g) * 8 + b) * 2 + 0) * 256) * 128 + hk * 64;
    const bf16_t* V1 = K1 + 256 * 128;
    const int lkey = tid >> 3, lch = tid & 7;
    const unsigned ko0 = (unsigned)lkey * 512u + (unsigned)lch * 16u, vo0 = (unsigned)lkey * (NPROJ * 2u) + (unsigned)lch * 16u, o1_ = (unsigned)lkey * 256u + (unsigned)lch * 16u;
    auto ldk = [&](int ti) -> u32x4 { const bool a = ti < nt0; const char* base = a ? (const char*)K0 + (size_t)ti * (64 * 512) : (const char*)K1 + (size_t)(ti - nt0) * (64 * 256); const unsigned off = a ? ko0 : o1_; return *(const u32x4*)(base + off); };
    auto ldv = [&](int ti) -> u32x4 { const bool a = ti < nt0; const char* base = a ? (const char*)V0 + (size_t)ti * (64 * NPROJ * 2) : (const char*)V1 + (size_t)(ti - nt0) * (64 * 256); const unsigned off = a ? vo0 : o1_; return *(const u32x4*)(base + off); };
    auto stage = [&](int buf, const u32x4& kv, const u32x4& vv) {
        unsigned char* kb = F.lds + buf * AT_BUFB; unsigned char* vb = kb + AT_TILEB;
        *(u32x4*)(kb + lkey * AT_ROWB + lch * 16) = kv;
        bf16_t* vt = (bf16_t*)vb + (lkey ^ (lch << 3));
        const int d0 = lch * 8;
        vt[(d0 + 0) * 72] = (bf16_t)(vv.x & 0xffff); vt[(d0 + 1) * 72] = (bf16_t)(vv.x >> 16); vt[(d0 + 2) * 72] = (bf16_t)(vv.y & 0xffff); vt[(d0 + 3) * 72] = (bf16_t)(vv.y >> 16);
        vt[(d0 + 4) * 72] = (bf16_t)(vv.z & 0xffff); vt[(d0 + 5) * 72] = (bf16_t)(vv.z >> 16); vt[(d0 + 6) * 72] = (bf16_t)(vv.w & 0xffff); vt[(d0 + 7) * 72] = (bf16_t)(vv.w >> 16);
    };
    float mrun, lrun;
    if (g == 0) { mrun = F.in[30][l * 4 + hq] * LOG2E; lrun = hi ? 0.f : 1.f; } else { mrun = -1e30f; lrun = 0.f; }
    f32x16 o0, o1;
#pragma unroll
    for (int r = 0; r < 16; ++r) { o0[r] = 0.f; o1[r] = 0.f; }
    __syncthreads();
    u32x4 kreg = ldk(0), vreg = ldv(0);
    stage(0, kreg, vreg);
    if (NT > 1) { kreg = ldk(1); vreg = ldv(1); }
    __syncthreads();
    const bool band = lat && g == 0;
    for (int ti = 0; ti < NT; ++ti) {
        const unsigned char* kb = F.lds + (ti & 1) * AT_BUFB; const unsigned char* vb = kb + AT_TILEB;
        const bool s1 = ti >= nt0;
        if (ti == nt0) {
#pragma unroll
            for (int s = 0; s < 4; ++s) qr[s] = *(const bf16x8*)(F.lds + 40960 + w * 4096 + s * 1024 + lane * 16);
        }
        f32x16 p0, p1;
#pragma unroll
        for (int r = 0; r < 16; ++r) { p0[r] = 0.f; p1[r] = 0.f; }
#pragma unroll
        for (int s = 0; s < 4; ++s) {
            const bf16x8 ka = *(const bf16x8*)(kb + r32 * AT_ROWB + (16 * s + 8 * hi) * 2);
            const bf16x8 kc = *(const bf16x8*)(kb + (32 + r32) * AT_ROWB + (16 * s + 8 * hi) * 2);
            const bf16x8 qf = qr[s];
            p0 = __builtin_amdgcn_mfma_f32_32x32x16_bf16(ka, qf, p0, 0, 0, 0);
            p1 = __builtin_amdgcn_mfma_f32_32x32x16_bf16(kc, qf, p1, 0, 0, 0);
        }
        if (band && !s1) {
            const int kp0 = kstart + ti * 64;
#pragma unroll
            for (int r = 0; r < 16; ++r) { const int kp = kp0 + crow(r, hi); int dlt = qpos - kp; dlt = dlt < 0 ? -dlt : dlt; if (dlt > 128) p0[r] = -1e30f; int d2 = qpos - kp - 32; d2 = d2 < 0 ? -d2 : d2; if (d2 > 128) p1[r] = -1e30f; }
        }
        float rm = fmaxf(p0[0], p1[0]);
#pragma unroll
        for (int r = 1; r < 16; ++r) rm = fmaxf(rm, fmaxf(p0[r], p1[r]));
        rm = fmaxf(rm, shx(rm, 32, lane));
        const float mnew = fmaxf(mrun, rm), alpha = __builtin_amdgcn_exp2f(mrun - mnew); mrun = mnew;
        float rs = 0.f;
#pragma unroll
        for (int r = 0; r < 16; ++r) { p0[r] = __builtin_amdgcn_exp2f(p0[r] - mnew); p1[r] = __builtin_amdgcn_exp2f(p1[r] - mnew); rs += p0[r] + p1[r]; }
        lrun = lrun * alpha + rs;
        if (__builtin_amdgcn_ballot_w64(alpha != 1.0f) != 0ull) {
#pragma unroll
            for (int r = 0; r < 16; ++r) { o0[r] *= alpha; o1[r] *= alpha; }
        }
        bf16x8 pf[4];
        { u32x4 a; a.x = cvt_pk_bf16(p0[0], p0[1]); a.y = cvt_pk_bf16(p0[2], p0[3]); a.z = cvt_pk_bf16(p0[4], p0[5]); a.w = cvt_pk_bf16(p0[6], p0[7]); pf[0] = __builtin_bit_cast(bf16x8, a);
          a.x = cvt_pk_bf16(p0[8], p0[9]); a.y = cvt_pk_bf16(p0[10], p0[11]); a.z = cvt_pk_bf16(p0[12], p0[13]); a.w = cvt_pk_bf16(p0[14], p0[15]); pf[1] = __builtin_bit_cast(bf16x8, a);
          a.x = cvt_pk_bf16(p1[0], p1[1]); a.y = cvt_pk_bf16(p1[2], p1[3]); a.z = cvt_pk_bf16(p1[4], p1[5]); a.w = cvt_pk_bf16(p1[6], p1[7]); pf[2] = __builtin_bit_cast(bf16x8, a);
          a.x = cvt_pk_bf16(p1[8], p1[9]); a.y = cvt_pk_bf16(p1[10], p1[11]); a.z = cvt_pk_bf16(p1[12], p1[13]); a.w = cvt_pk_bf16(p1[14], p1[15]); pf[3] = __builtin_bit_cast(bf16x8, a); }
#pragma unroll
        for (int ks = 0; ks < 4; ++ks) {
            const int ka = (16 * ks + 4 * hi) ^ ((r32 >> 3) << 3), kc = ka ^ 32;
            const unsigned char* vp = vb + r32 * AT_ROWB;
            const u32x2 a0 = *(const u32x2*)(vp + ka * 2), a1 = *(const u32x2*)(vp + (ka ^ 8) * 2);
            const u32x2 c0 = *(const u32x2*)(vp + 32 * AT_ROWB + kc * 2), c1 = *(const u32x2*)(vp + 32 * AT_ROWB + (kc ^ 8) * 2);
            const u32x4 fa = (u32x4){a0.x, a0.y, a1.x, a1.y}, fc = (u32x4){c0.x, c0.y, c1.x, c1.y};
            o0 = __builtin_amdgcn_mfma_f32_32x32x16_bf16(__builtin_bit_cast(bf16x8, fa), pf[ks], o0, 0, 0, 0);
            o1 = __builtin_amdgcn_mfma_f32_32x32x16_bf16(__builtin_bit_cast(bf16x8, fc), pf[ks], o1, 0, 0, 0);
        }
        if (ti + 1 < NT) { stage((ti + 1) & 1, kreg, vreg); if (ti + 2 < NT) { kreg = ldk(ti + 2); vreg = ldv(ti + 2); } }
        __syncthreads();
    }
    lrun += shx(lrun, 32, lane);
    const float inv = 1.f / lrun;
    bf16_t* op = MERGED + (size_t)tok * DM + (g ? 512 : 256) + hq * 64 + 4 * hi;
#pragma unroll
    for (int i = 0; i < 4; ++i) {
        u32x2 a; a.x = cvt_pk_bf16(o0[4 * i] * inv, o0[4 * i + 1] * inv); a.y = cvt_pk_bf16(o0[4 * i + 2] * inv, o0[4 * i + 3] * inv);
        u32x2 c; c.x = cvt_pk_bf16(o1[4 * i] * inv, o1[4 * i + 1] * inv); c.y = cvt_pk_bf16(o1[4 * i + 2] * inv, o1[4 * i + 3] * inv);
        *(u32x2*)(op + 8 * i) = a; *(u32x2*)(op + 32 + 8 * i) = c;
    }
}
DI void attn_phase(unsigned char* lds_, int wv_, int l) {
    Frame F = mkframe(lds_, wv_);
    for (int u = F.bid; u < 512; u += F.G) attn_unit(F, l, 1, true, u >> 6, (u >> 5) & 1, u & 31);
    for (int u = F.bid; u < 512; u += F.G) attn_unit(F, l, 0, true, u >> 6, (u >> 5) & 1, u & 31);
    for (int u = F.bid; u < 256; u += F.G) attn_unit(F, l, u >> 7, false, (u >> 2) & 31, (u >> 1) & 1, u & 1);
    __syncthreads();
}

DI void ph_gateup(unsigned char* lds_, int wv_, int l, int f) { Frame F = mkframe(lds_, wv_);
    pg8::SchedStd S; S.init((const unsigned char*)F.out, F.ws + OFF_WGU + (size_t)(l * 2 + f) * SZ_WGU, DM * 2, DM * 2, T_ALL, 2 * FF, F.G, F.bid);
    pg8::EpiSwiglu E{(bf16_t*)(F.ws + OFF_HID)}; pg8::gemm_phase<true>(F.ldsl, fresh(F.tid), pg8::Cfg{DM * 2, DM * 2, DM}, S, E); }
template <bool IN32, bool OUT32>
DI void down_gemms(Frame& F, const void* h0, const void* h1, void* ho, const float* gate, const unsigned char* W) {
    { pg8::SchedStd S; S.init(F.ws + OFF_HID, W, FF * 2, FF * 2, 128 * 256, DM, F.G, F.bid);
      pg8::EpiResid<IN32, OUT32> E{h0, h1, ho, gate, 0.5f}; pg8::gemm_phase<false>(F.ldsl, fresh(F.tid), pg8::Cfg{FF * 2, FF * 2, FF}, S, E); }
    { pg8::SchedHN S{(const char*)(F.ws + OFF_HID), (const char*)W, FF * 2, FF * 2, F.G, F.bid};
      pg8::EpiResidHN<IN32, OUT32> E{h0, h1, ho, gate, 0.5f}; pg8::gemm_phase_hn<false>(F.ldsl, fresh(F.tid), pg8::Cfg{FF * 2, FF * 2, FF}, S, E); }
}
DI void ph_down(unsigned char* lds_, int wv_, int l, int f, bool first) { Frame F = mkframe(lds_, wv_);
    bf16_t* HB = (bf16_t*)(F.ws + OFF_HB);
    const float* gate = (const float*)(F.ws + OFF_MOD) + (size_t)l * 9 * 9216 + (f ? 8 : 2) * 1024;
    const unsigned char* W = F.ws + OFF_WDN + (size_t)(l * 2 + f) * SZ_WDN;
    if (first) down_gemms<true, false>(F, F.in[0], F.in[1], HB, gate, W);
    else if (l == 1 && f == 1) down_gemms<false, true>(F, HB, HB + (size_t)T_CTX * DM, F.out, gate, W);
    else down_gemms<false, false>(F, HB, HB + (size_t)T_CTX * DM, HB, gate, W);
}
DI void ph_win(unsigned char* lds_, int wv_, int l) { Frame F = mkframe(lds_, wv_);
    const unsigned char* XN = (const unsigned char*)F.out; const unsigned char* WIN = F.ws + OFF_WIN + (size_t)l * NPROJ * DM * 2; const unsigned char* WINF = F.ws + OFF_WINF + (size_t)l * 512 * DM * 2;
    { pg8::SchedStd S; S.init(XN, WIN, DM * 2, DM * 2, 153 * 256, NPROJ, F.G, F.bid);
      pg8::EpiStore E{(bf16_t*)(F.ws + OFF_PROJ), NPROJ}; pg8::gemm_phase<true>(F.ldsl, fresh(F.tid), pg8::Cfg{DM * 2, DM * 2, DM}, S, E); }
    { pg8::SchedStd S; S.init(WINF, XN, DM * 2, DM * 2, 512, 128 * 256, F.G, F.bid);
      pg8::EpiStore E{(bf16_t*)(F.ws + OFF_PQT), T_ALL}; pg8::gemm_phase<true>(F.ldsl, fresh(F.tid), pg8::Cfg{DM * 2, DM * 2, DM}, S, E); }
    { pg8::SchedWinTail S{(const char*)XN, (const char*)WIN, (const char*)WINF, F.G, F.bid};
      pg8::EpiStoreHN E{(bf16_t*)(F.ws + OFF_PROJ), NPROJ, (ptrdiff_t)OFF_PQT - (ptrdiff_t)OFF_PROJ, T_ALL}; pg8::gemm_phase_hn<true>(F.ldsl, fresh(F.tid), pg8::Cfg{DM * 2, DM * 2, DM}, S, E); } }
DI void dft_row0(unsigned char* lds_, int wv_) { Frame F = mkframe(lds_, wv_);
    const int gw = F.bid * NWAVES + F.wave, NGW = F.G * NWAVES;
    const bf16_t* PQT = (const bf16_t*)(F.ws + OFF_PQT); bf16_t* FCS = (bf16_t*)(F.out);
    for (int t = gw; t < 8 * 256; t += NGW) { const int b = t >> 8, ch = t & 255; const int seq0 = T_CTX + b * 4096;
        const bf16_t* p = PQT + (size_t)ch * T_ALL + seq0 + F.lane * 8; float a = 0.f;
#pragma unroll
        for (int q = 0; q < 8; ++q) { const u32x4 v = *(const u32x4*)(p + q * 512); a += (bflo(v.x) + bfhi(v.x)) + (bflo(v.y) + bfhi(v.y)) + (bflo(v.z) + bfhi(v.z)) + (bflo(v.w) + bfhi(v.w)); }
        a = wave_sum(a, F.lane);
        if (F.lane == 0) FCS[(size_t)seq0 * 1024 + ch] = (bf16_t)f2bf(a * (1.f / 64.f));
        if (ch == 0) { bf16_t* z = FCS + (size_t)seq0 * 1024 + 256 + F.lane * 12;
            *(u32x2*)z = (u32x2){0u, 0u}; *(u32x2*)(z + 4) = (u32x2){0u, 0u}; *(u32x2*)(z + 8) = (u32x2){0u, 0u}; } }
}
DI void ph_dft(unsigned char* lds_, int wv_) { Frame F = mkframe(lds_, wv_);
    { pg8::SchedDftLat S{(const char*)(F.ws + OFF_TC4), OFF_TS4 - OFF_TC4, (const char*)(F.ws + OFF_PQT), F.G, F.bid};
      pg8::EpiDftSym E{(bf16_t*)(F.out)}; pg8::gemm_phase<true>(F.ldsl, fresh(F.tid), pg8::Cfg{8192, T_ALL * 2, 2048}, S, E); }
    { pg8::SchedDftCtx S{(const char*)(F.ws + OFF_TC2), OFF_TS2 - OFF_TC2, (const char*)(F.ws + OFF_PQT), F.G, F.bid};
      pg8::EpiDftCtx E{(bf16_t*)(F.out)}; pg8::gemm_phase<true>(F.ldsl, fresh(F.tid), pg8::Cfg{512, T_ALL * 2, 256}, S, E); } }
DI void ph_post(unsigned char* lds_, int wv_, int l) { Frame F = mkframe(lds_, wv_);
    { pg8::SchedStd S; S.init(F.ws + OFF_YS, F.ws + OFF_WGLU + (size_t)l * 65536 * 2, 512, 512, T_ALL, 256, F.G, F.bid);
      pg8::EpiGlu E{(const bf16_t*)(F.ws + OFF_YS), F.in[29] + l * 256, (bf16_t*)(F.ws + OFF_MERGED)}; pg8::gemm_phase<true>(F.ldsl, fresh(F.tid), pg8::Cfg{512, 512, 256}, S, E); }
    { pg8::SchedStd S; S.init((const unsigned char*)F.out, F.ws + OFF_WFN + (size_t)l * 256 * 1024 * 2, 2048, 2048, T_ALL, 256, F.G, F.bid);
      pg8::EpiBias E{F.in[34] + l * 256, (bf16_t*)(F.ws + OFF_MERGED), 768}; pg8::gemm_phase<true>(F.ldsl, fresh(F.tid), pg8::Cfg{2048, 2048, 1024}, S, E); } }
DI void ph_wout(unsigned char* lds_, int wv_, int l) { Frame F = mkframe(lds_, wv_);
    bf16_t* HB = (bf16_t*)(F.ws + OFF_HB); const float* gate = (const float*)(F.ws + OFF_MOD) + (size_t)l * 9 * 9216 + 5 * 1024;
    const unsigned char* W = F.ws + OFF_WOUT + (size_t)l * DM * DM * 2;
    { pg8::SchedStd S; S.init(F.ws + OFF_MERGED, W, DM * 2, DM * 2, 128 * 256, DM, F.G, F.bid);
      pg8::EpiResid<false, false> E{HB, HB + (size_t)T_CTX * DM, HB, gate, 1.0f}; pg8::gemm_phase<false>(F.ldsl, fresh(F.tid), pg8::Cfg{DM * 2, DM * 2, DM}, S, E); }
    { pg8::SchedHN S{(const char*)(F.ws + OFF_MERGED), (const char*)W, DM * 2, DM * 2, F.G, F.bid};
      pg8::EpiResidHN<false, false> E{HB, HB + (size_t)T_CTX * DM, HB, gate, 1.0f}; pg8::gemm_phase_hn<false>(F.ldsl, fresh(F.tid), pg8::Cfg{DM * 2, DM * 2, DM}, S, E); } }

__global__ void __launch_bounds__(NTHREADS, 2) mega_fwd(Params P) {
    extern __shared__ __attribute__((aligned(16))) unsigned char lds[];
    cg::grid_group grid = cg::this_grid();
#define GSYNC() do { asm volatile("s_waitcnt vmcnt(0) lgkmcnt(0)" ::: "memory"); grid.sync(); __builtin_amdgcn_fence(__ATOMIC_ACQUIRE, "agent"); asm volatile("s_waitcnt vmcnt(0)" ::: "memory"); } while (0)
    const int wv0 = __builtin_amdgcn_readfirstlane((int)(threadIdx.x >> 6));
    if (threadIdx.x == 0) {
#pragma unroll
        for (int i = 0; i < 36; ++i) *(unsigned long long*)(lds + PTAB_OFF + 8 * i) = (unsigned long long)P.in[i];
        *(unsigned long long*)(lds + PTAB_OFF + 8 * 36) = (unsigned long long)P.out; *(unsigned long long*)(lds + PTAB_OFF + 8 * 37) = (unsigned long long)P.ws;
        *(unsigned*)(lds + XBST_OFF) = 0u; *(unsigned*)(lds + XBST_OFF + 4) = 0u;
        (void)xb_add((unsigned*)(P.ws + OFF_CTL) + XB_XCNT(xb_xcc_id()), 1u); }
    __syncthreads();
#undef GSYNC
#define GSYNC() xcd_sync(lds, wv0)
    if (gridDim.x == 0x7fffffffu) grid.sync();
    p0_phase(lds, wv0);
    GSYNC();
#define FFN_PHASES(l, f, first) do { norm_phase(lds, wv0, l, (f) ? 2 : 0, first); GSYNC(); ph_gateup(lds, wv0, l, f); GSYNC(); ph_down(lds, wv0, l, f, first); GSYNC(); } while (0)
#define MIX_PHASES(l) do { norm_phase(lds, wv0, l, 1, false); GSYNC(); ph_win(lds, wv0, l); GSYNC(); kprep_phase(lds, wv0, l); s5_pass1(lds, wv0, l); GSYNC(); \
        attn_phase(lds, wv0, l); dft_row0(lds, wv0); ph_dft(lds, wv0); __syncthreads(); s5_pass2(lds, wv0, l); GSYNC(); ph_post(lds, wv0, l); GSYNC(); ph_wout(lds, wv0, l); GSYNC(); } while (0)
    FFN_PHASES(0, 0, true); MIX_PHASES(0); FFN_PHASES(0, 1, false);
    FFN_PHASES(1, 0, false); MIX_PHASES(1); FFN_PHASES(1, 1, false);
    final_norm_phase(lds, wv0);
}

extern "C" void kernel_launch(void* const* d_in, const int* in_sizes, int n_in, void* d_out, int out_size, void* d_ws, size_t ws_size, hipStream_t stream) {
    static int grid = 0;
    if (grid == 0) {
        int dev = 0, cus = 0, per_cu = 0;
        hipGetDevice(&dev);
        hipDeviceGetAttribute(&cus, hipDeviceAttributeMultiprocessorCount, dev);
        if (hipFuncSetAttribute((const void*)mega_fwd, hipFuncAttributeMaxDynamicSharedMemorySize, LDS_BYTES) != hipSuccess) { fprintf(stderr, "hipFuncSetAttribute failed\n"); }
        if (hipOccupancyMaxActiveBlocksPerMultiprocessor(&per_cu, (const void*)mega_fwd, NTHREADS, LDS_BYTES) != hipSuccess || per_cu < 1) { fprintf(stderr, "occupancy query: %d\n", per_cu); per_cu = 1; }
        (void)hipGetLastError();
        grid = cus * 1;
        if (n_in != 36 || ws_size < WS_TOTAL) { fprintf(stderr, "kernel_launch: unexpected n_in %d / ws %zu (need %zu)\n", n_in, ws_size, (size_t)WS_TOTAL); grid = -1; }
    }
    if (grid < 0) return;
    if (hipMemsetAsync((char*)d_ws + OFF_CTL, 0, CTL_BYTES, stream) != hipSuccess) { fprintf(stderr, "memset failed\n"); return; }
    Params p{};
    for (int i = 0; i < 36; ++i) p.in[i] = (const float*)d_in[i];
    p.out = (float*)d_out; p.ws = (unsigned char*)d_ws;
    void* args[] = {&p};
    hipError_t e = hipLaunchCooperativeKernel((const void*)mega_fwd, dim3(grid), dim3(NTHREADS), args, LDS_BYTES, stream);
    if (e != hipSuccess) fprintf(stderr, "cooperative launch failed: %s (grid %d)\n", hipGetErrorString(e), grid);
}
```

```cpp
#include <hip/hip_runtime.h>
#include <hip/hip_cooperative_groups.h>
#include <cstdio>
#include <cstdint>
namespace cg = cooperative_groups;

#define DI __device__ __forceinline__
#define LAS __attribute__((address_space(3)))
typedef unsigned short bf16_t;
typedef short bf16x8 __attribute__((ext_vector_type(8)));
typedef float f32x4 __attribute__((ext_vector_type(4)));
typedef float f32x2 __attribute__((ext_vector_type(2)));
typedef float f32x16 __attribute__((ext_vector_type(16)));
typedef unsigned u32x4 __attribute__((ext_vector_type(4)));
typedef unsigned u32x2 __attribute__((ext_vector_type(2)));

constexpr int DM = 1024, FF = 2816, T_CTX = 8192, T_LAT = 32768, T_ALL = 40960, NPROJ = 1280, NMOD = 9;
constexpr int NTHREADS = 512, NWAVES = 8;
constexpr float EPSF = 1e-6f;
constexpr float C2 = 0.125f * 1.4426950408889634f;
constexpr float LOG2E = 1.4426950408889634f;

constexpr size_t SZ_WGU = (size_t)2 * FF * DM * 2, SZ_WDN = (size_t)DM * FF * 2;
constexpr size_t OFF_WGU = 0;
constexpr size_t OFF_WDN = OFF_WGU + 4 * SZ_WGU;
constexpr size_t OFF_WIN = OFF_WDN + 4 * SZ_WDN;
constexpr size_t OFF_WINF = OFF_WIN + 2 * (size_t)NPROJ * DM * 2;
constexpr size_t OFF_WOUT = OFF_WINF + 2 * (size_t)512 * DM * 2;
constexpr size_t OFF_WGLU = OFF_WOUT + 2 * (size_t)DM * DM * 2;
constexpr size_t OFF_WFN = OFF_WGLU + 2 * (size_t)256 * 256 * 2;
constexpr size_t OFF_TC4 = OFF_WFN + 2 * (size_t)256 * 1024 * 2;
constexpr size_t OFF_TS4 = OFF_TC4 + (size_t)2056 * 4096 * 2;
constexpr size_t OFF_TC2 = OFF_TS4 + (size_t)2056 * 4096 * 2;
constexpr size_t OFF_TS2 = OFF_TC2 + (size_t)256 * 256 * 2;
constexpr size_t OFF_MOD = OFF_TS2 + (size_t)256 * 256 * 2;
constexpr size_t OFF_ROPE = OFF_MOD + (size_t)2 * 9 * 9216 * 4;
constexpr size_t OFF_CKV = OFF_ROPE + (size_t)4096 * 32 * 8;
constexpr size_t OFF_ESTC = OFF_CKV + (size_t)2 * 2 * 8 * 2 * 256 * 128 * 2;
constexpr size_t OFF_ESTL = OFF_ESTC + (size_t)32 * 16 * 2 * 2 * 64 * 8;
constexpr size_t OFF_XN = OFF_ESTL + (size_t)8 * 16 * 2 * 32 * 64 * 8;
constexpr size_t OFF_HB = OFF_XN;
constexpr size_t OFF_FCS = OFF_XN;
constexpr size_t OFF_HID = OFF_XN + (size_t)T_ALL * DM * 2;
constexpr size_t OFF_PROJ = OFF_HID;
constexpr size_t OFF_MERGED = OFF_PROJ + (size_t)T_ALL * NPROJ * 2;
constexpr size_t OFF_PQT = OFF_MERGED + (size_t)T_ALL * DM * 2;
constexpr size_t WS_END = OFF_HID + (size_t)T_ALL * FF * 2;
constexpr size_t OFF_CTL = WS_END, CTL_BYTES = 16384;
constexpr size_t OFF_W128 = WS_END + CTL_BYTES;
constexpr size_t OFF_YS = OFF_W128 + (size_t)2 * 2 * 16 * 128 * 2048 * 2;
constexpr size_t OFF_KR = OFF_YS + (size_t)T_ALL * 256 * 2;
constexpr size_t WS_TOTAL = OFF_KR + (size_t)T_ALL * 256 * 2;
static_assert(OFF_PQT + (size_t)512 * T_ALL * 2 <= WS_END, "overlay");
static_assert(WS_TOTAL <= (size_t)536870912, "ws budget");
static_assert(OFF_XN % 256 == 0 && OFF_HID % 256 == 0 && OFF_TC4 % 256 == 0, "align");

constexpr size_t OUT_SWA = (size_t)T_ALL * DM;
constexpr size_t OUT_AX = OUT_SWA + (size_t)32 * 2 * 2 * 256 * 128;
constexpr size_t OUT_SSM = OUT_AX + (size_t)32 * 2 * 2 * 256 * 128;

constexpr int LDS_BYTES = 131072 + 1024;

struct Params { const float* in[36]; float* out; unsigned char* ws; };

DI unsigned cvt_pk_bf16(float lo, float hi) { unsigned r; asm volatile("v_cvt_pk_bf16_f32 %0, %1, %2" : "=v"(r) : "v"(lo), "v"(hi)); return r; }
typedef __bf16 bf16x2_t __attribute__((ext_vector_type(2)));
DI unsigned cvt_pk_bf16_c(float lo, float hi) { const f32x2 v = {lo, hi}; const bf16x2_t b = __builtin_convertvector(v, bf16x2_t); return __builtin_bit_cast(unsigned, b); }
DI unsigned f2bf(float f) { unsigned u = __float_as_uint(f); return (u + 0x7fffu + ((u >> 16) & 1u)) >> 16; }
DI float bflo(unsigned w) { return __uint_as_float(w << 16); }
DI float bfhi(unsigned w) { return __uint_as_float(w & 0xffff0000u); }
DI float bf1(bf16_t v) { return __uint_as_float(((unsigned)v) << 16); }
DI float shx(float v, int o, int lane) { return __int_as_float(__builtin_amdgcn_ds_bpermute((lane ^ o) << 2, __float_as_int(v))); }
DI float wave_sum(float v, int lane) {
#pragma unroll
    for (int o = 1; o < 64; o <<= 1) v += shx(v, o, lane);
    return v;
}
DI int fresh(int v) { asm volatile("" : "+v"(v)); return v; }
DI float silu_f(float x) { return x / (1.f + __expf(-x)); }
DI float sigmoid_f(float x) { return 1.f / (1.f + __expf(-x)); }
DI float gelu_tanh(float x) { const float z = 0.7978845608028654f * (x + 0.044715f * x * x * x); const float e = __expf(2.f * z); return 0.5f * x * (2.f - 2.f / (e + 1.f)); }

namespace pg8 {
constexpr int BM = 256, BK = 64, HALF = 128, HTB = HALF * BK * 2, NXCD = 8, WGM = 8;
__host__ __device__ __forceinline__ int lds_byte(int r, int c) { const int st = (r >> 4) * 2 + (c >> 5), rr = r & 15, cc = c & 31, ob = rr * 64 + cc * 2; return st * 1024 + (ob ^ (((ob >> 9) & 1) << 5)); }
__host__ __device__ __forceinline__ void stage_rc(int b, int& R, int& C) { const int st = b / 1024, sb = b % 1024, swz = sb ^ (((sb >> 9) & 1) << 5); R = (st >> 1) * 16 + swz / 64; C = (st & 1) * 32 + (swz % 64) / 2; }
__host__ __device__ __forceinline__ int perm32(int rho) { const int n = rho >> 4, i = rho & 15; return 8 * (i >> 2) + 4 * n + (i & 3); }

struct Unit { const char* A; const char* B; int pm, pn; };
struct Cfg { unsigned lda, ldb; int K; };

struct SchedStd {
    const char* A; const char* B; unsigned lda, ldb; int nM, nN, nwg, G, c;
    DI void init(const void* A_, const void* B_, unsigned lda_, unsigned ldb_, int M, int N, int G_, int c_) { A = (const char*)A_; B = (const char*)B_; lda = lda_; ldb = ldb_; nM = M / BM; nN = N / BM; nwg = nM * nN; G = G_; c = c_; }
    DI bool next(int i, Unit& u) const {
        const long L = (long)i * G + c; if (L >= nwg) return false;
        int wgid = (int)L; { const int q = nwg / NXCD, r = nwg % NXCD, xcd = wgid % NXCD, off = wgid / NXCD; wgid = (xcd < r ? xcd * (q + 1) : r * (q + 1) + (xcd - r) * q) + off; }
        const int nig = WGM * nN, gid = wgid / nig, fm = gid * WGM, gsz = (nM - fm) < WGM ? (nM - fm) : WGM;
        u.pm = fm + ((wgid % nig) % gsz); u.pn = (wgid % nig) / gsz;
        u.A = A + (size_t)u.pm * BM * lda; u.B = B + (size_t)u.pn * BM * ldb; return true;
    }
};

template <bool PERM, class Sched, class Epi>
DI void gemm_phase(LAS unsigned char* lds, const int tid, const Cfg g, const Sched& S, const Epi& E) {
    const int wid = __builtin_amdgcn_readfirstlane(tid >> 6), lane = tid & 63, wr = wid >> 2, wc = wid & 3, fr = lane & 15, fq = lane >> 4;
    const int nt = g.K / BK;
    unsigned voffA[2], voffB[2];
#pragma unroll
    for (int i = 0; i < 2; ++i) { int R, C; stage_rc(tid * 16 + i * 8192, R, C); const int Rb = PERM ? ((R & ~31) + perm32(R & 31)) : R;
        voffA[i] = (unsigned)R * g.lda + (unsigned)C * 2u; voffB[i] = (unsigned)Rb * g.ldb + (unsigned)C * 2u; }
    const size_t kstep = (size_t)(BK * 2);
    const size_t hsA = (size_t)HALF * g.lda, hsB = (size_t)HALF * g.ldb;
    const unsigned ldsw = (unsigned)wid * 1024u;
    const int aoff = lds_byte(wr * 64 + fr, fq * 8), boff = lds_byte(wc * 32 + fr, fq * 8);
#define PG8_SA(b, h) (((b) * 2 + (h)) * HTB)
#define PG8_SB(b, h) ((4 + (b) * 2 + (h)) * HTB)
#define PG8_STAGE(bufoff, gbase, voff) do { const char* _gb = (const char*)(gbase); asm volatile("" : "+s"(_gb));   \
        _Pragma("unroll") for (int _i = 0; _i < 2; ++_i) \
        __builtin_amdgcn_global_load_lds((const unsigned*)(_gb + (voff)[_i]), (LAS unsigned*)(lds + (bufoff) + ldsw + _i * 8192), 16, 0, 0); } while (0)
#define PG8_LDA(dst, b, h) do { _Pragma("unroll") for (int m = 0; m < 4; ++m) _Pragma("unroll") for (int k = 0; k < 2; ++k) dst[m][k] = *(const LAS bf16x8*)(lds + PG8_SA(b, h) + aoff + m * 2048 + k * 1024); } while (0)
#define PG8_LDB(dst, b, h) do { _Pragma("unroll") for (int n = 0; n < 2; ++n) _Pragma("unroll") for (int k = 0; k < 2; ++k) dst[n][k] = *(const LAS bf16x8*)(lds + PG8_SB(b, h) + boff + n * 2048 + k * 1024); } while (0)
#define PG8_MMA(ai, bj, At, Bt) do { __builtin_amdgcn_s_setprio(1); _Pragma("unroll") for (int m = 0; m < 4; ++m) _Pragma("unroll") for (int n = 0; n < 2; ++n) _Pragma("unroll") for (int k = 0; k < 2; ++k) \
        acc[ai][bj][m][n] = __builtin_amdgcn_mfma_f32_16x16x32_bf16(Bt[n][k], At[m][k], acc[ai][bj][m][n], 0, 0, 0); __builtin_amdgcn_s_setprio(0); } while (0)
#define PG8_WAIT_V(n) asm volatile("s_waitcnt vmcnt(" #n ")" ::: "memory")
#define PG8_WAIT_L(n) asm volatile("s_waitcnt lgkmcnt(" #n ")" ::: "memory")
#define PG8_BAR __builtin_amdgcn_s_barrier()
#define PG8_SCHED __builtin_amdgcn_sched_barrier(0)
    Unit cur, nxt; int ui = 0;
    if (!S.next(0, cur)) return;
    f32x4 acc[2][2][4][2];
#pragma unroll
    for (int a = 0; a < 2; ++a)
#pragma unroll
        for (int b = 0; b < 2; ++b)
#pragma unroll
            for (int m = 0; m < 4; ++m)
#pragma unroll
                for (int n = 0; n < 2; ++n) acc[a][b][m][n] = (f32x4){0.f, 0.f, 0.f, 0.f};
    bf16x8 At[4][2], B0[2][2], B1[2][2];
    const char* cA = cur.A; const char* cB = cur.B;
    PG8_STAGE(PG8_SB(0, 0), cB, voffB); PG8_STAGE(PG8_SB(0, 1), cB + hsB, voffB); PG8_STAGE(PG8_SA(0, 0), cA, voffA); PG8_STAGE(PG8_SA(0, 1), cA + hsA, voffA);
    if (wr == 1) PG8_BAR;
    PG8_WAIT_V(2); PG8_BAR;
    PG8_STAGE(PG8_SB(1, 0), cB + kstep, voffB); PG8_STAGE(PG8_SA(1, 0), cA + kstep, voffA); PG8_STAGE(PG8_SB(1, 1), cB + hsB + kstep, voffB);
    PG8_WAIT_V(6); PG8_BAR;
    for (;;) {
        const bool has_next = S.next(ui + 1, nxt);
        const char* nA = has_next ? nxt.A : cA; const char* nB = has_next ? nxt.B : cB;
        for (int t = 0; t < nt; t += 2) {
            const bool last = (t == nt - 2);
            const char* a1 = cA + (size_t)(t + 1) * kstep;
            const char* a2 = last ? nA : cA + (size_t)(t + 2) * kstep; const char* b2 = last ? nB : cB + (size_t)(t + 2) * kstep;
            const char* a3 = a2 + kstep; const char* b3 = b2 + kstep;
            PG8_LDB(B0, 0, 0); PG8_LDB(B1, 0, 1); PG8_SCHED; PG8_LDA(At, 0, 0); PG8_STAGE(PG8_SA(1, 1), a1 + hsA, voffA);
            PG8_WAIT_V(8); PG8_WAIT_L(0); PG8_BAR; PG8_MMA(0, 0, At, B0); PG8_MMA(0, 1, At, B1); PG8_BAR; PG8_SCHED;
            PG8_LDA(At, 0, 1); PG8_STAGE(PG8_SB(0, 0), b2, voffB); PG8_STAGE(PG8_SB(0, 1), b2 + hsB, voffB); PG8_STAGE(PG8_SA(0, 0), a2, voffA);
            PG8_WAIT_V(8); PG8_WAIT_L(0); PG8_BAR; PG8_MMA(1, 0, At, B0); PG8_MMA(1, 1, At, B1); PG8_BAR; PG8_SCHED;
            PG8_LDB(B0, 1, 0); PG8_LDB(B1, 1, 1); PG8_SCHED; PG8_LDA(At, 1, 0); PG8_STAGE(PG8_SA(0, 1), a2 + hsA, voffA);
            PG8_WAIT_V(8); PG8_WAIT_L(0); PG8_BAR; PG8_MMA(0, 0, At, B0); PG8_MMA(0, 1, At, B1); PG8_BAR; PG8_SCHED;
            PG8_LDA(At, 1, 1); PG8_STAGE(PG8_SB(1, 0), b3, voffB); PG8_STAGE(PG8_SB(1, 1), b3 + hsB, voffB); PG8_STAGE(PG8_SA(1, 0), a3, voffA);
            PG8_WAIT_V(8); PG8_WAIT_L(0); PG8_BAR; PG8_MMA(1, 0, At, B0); PG8_MMA(1, 1, At, B1); PG8_BAR; PG8_SCHED;
        }
        if (wr == 0) PG8_BAR;
        E(acc, cur, wr, wc, fr, fq);
        if (!has_next) break;
#pragma unroll
        for (int a = 0; a < 2; ++a)
#pragma unroll
            for (int b = 0; b < 2; ++b)
#pragma unroll
                for (int m = 0; m < 4; ++m)
#pragma unroll
                    for (int n = 0; n < 2; ++n) acc[a][b][m][n] = (f32x4){0.f, 0.f, 0.f, 0.f};
        cur = nxt; cA = nA; cB = nB; ++ui;
        if (wr == 1) PG8_BAR;
    }
    PG8_WAIT_V(0);
    PG8_BAR;
#undef PG8_SA
#undef PG8_SB
#undef PG8_STAGE
#undef PG8_LDA
#undef PG8_LDB
#undef PG8_MMA
#undef PG8_WAIT_V
#undef PG8_WAIT_L
#undef PG8_BAR
#undef PG8_SCHED
}

template <bool PERM, class Sched, class Epi>
DI void gemm_phase_hn(LAS unsigned char* lds, const int tid, const Cfg g, const Sched& S, const Epi& E) {
    const int wid = __builtin_amdgcn_readfirstlane(tid >> 6), lane = tid & 63, wr = wid >> 2, wc = wid & 3, fr = lane & 15, fq = lane >> 4;
    const int nt = g.K / BK;
    unsigned voffA[2], voffB[2];
#pragma unroll
    for (int i = 0; i < 2; ++i) { int R, C; stage_rc(tid * 16 + i * 8192, R, C); const int Rb = PERM ? ((R & ~31) + perm32(R & 31)) : R;
        voffA[i] = (unsigned)R * g.lda + (unsigned)C * 2u; voffB[i] = (unsigned)Rb * g.ldb + (unsigned)C * 2u; }
    const size_t kstep = (size_t)(BK * 2);
    const size_t hsA = (size_t)HALF * g.lda;
    const unsigned ldsw = (unsigned)wid * 1024u;
    const int aoff = lds_byte(wr * 64 + fr, fq * 8), boff = lds_byte(wc * 32 + fr, fq * 8);
#define PG8_SA(b, h) (((b) * 2 + (h)) * HTB)
#define PG8_SB(b, h) ((4 + (b) * 2 + (h)) * HTB)
#define PG8_STAGE(bufoff, gbase, voff) do { const char* _gb = (const char*)(gbase); asm volatile("" : "+s"(_gb));   \
        _Pragma("unroll") for (int _i = 0; _i < 2; ++_i) \
        __builtin_amdgcn_global_load_lds((const unsigned*)(_gb + (voff)[_i]), (LAS unsigned*)(lds + (bufoff) + ldsw + _i * 8192), 16, 0, 0); } while (0)
#define PG8_LDA(dst, b, h) do { _Pragma("unroll") for (int m = 0; m < 4; ++m) _Pragma("unroll") for (int k = 0; k < 2; ++k) dst[m][k] = *(const LAS bf16x8*)(lds + PG8_SA(b, h) + aoff + m * 2048 + k * 1024); } while (0)
#define PG8_LDB(dst, b, h) do { _Pragma("unroll") for (int n = 0; n < 2; ++n) _Pragma("unroll") for (int k = 0; k < 2; ++k) dst[n][k] = *(const LAS bf16x8*)(lds + PG8_SB(b, h) + boff + n * 2048 + k * 1024); } while (0)
#define PG8_MMA(ai, bj, At, Bt) do { __builtin_amdgcn_s_setprio(1); _Pragma("unroll") for (int m = 0; m < 4; ++m) _Pragma("unroll") for (int n = 0; n < 2; ++n) _Pragma("unroll") for (int k = 0; k < 2; ++k) \
        acc[ai][bj][m][n] = __builtin_amdgcn_mfma_f32_16x16x32_bf16(Bt[n][k], At[m][k], acc[ai][bj][m][n], 0, 0, 0); __builtin_amdgcn_s_setprio(0); } while (0)
#define PG8_WAIT_V(n) asm volatile("s_waitcnt vmcnt(" #n ")" ::: "memory")
#define PG8_WAIT_L(n) asm volatile("s_waitcnt lgkmcnt(" #n ")" ::: "memory")
#define PG8_BAR __builtin_amdgcn_s_barrier()
#define PG8_SCHED __builtin_amdgcn_sched_barrier(0)
    Unit cur, nxt; int ui = 0;
    if (!S.next(0, cur)) return;
    f32x4 acc[2][1][4][2];
#pragma unroll
    for (int a = 0; a < 2; ++a)
#pragma unroll
        for (int b = 0; b < 1; ++b)
#pragma unroll
            for (int m = 0; m < 4; ++m)
#pragma unroll
                for (int n = 0; n < 2; ++n) acc[a][b][m][n] = (f32x4){0.f, 0.f, 0.f, 0.f};
    bf16x8 At[4][2], B0[2][2];
    const char* cA = cur.A; const char* cB = cur.B;
    PG8_STAGE(PG8_SB(0, 0), cB, voffB); PG8_STAGE(PG8_SA(0, 0), cA, voffA); PG8_STAGE(PG8_SA(0, 1), cA + hsA, voffA);
    if (wr == 1) PG8_BAR;
    PG8_WAIT_V(2); PG8_BAR;
    PG8_STAGE(PG8_SB(1, 0), cB + kstep, voffB); PG8_STAGE(PG8_SA(1, 0), cA + kstep, voffA);
    PG8_WAIT_V(4); PG8_BAR;
    for (;;) {
        const bool has_next = S.next(ui + 1, nxt);
        const char* nA = has_next ? nxt.A : cA; const char* nB = has_next ? nxt.B : cB;
        for (int t = 0; t < nt; t += 2) {
            const bool last = (t == nt - 2);
            const char* a1 = cA + (size_t)(t + 1) * kstep;
            const char* a2 = last ? nA : cA + (size_t)(t + 2) * kstep; const char* b2 = last ? nB : cB + (size_t)(t + 2) * kstep;
            const char* a3 = a2 + kstep; const char* b3 = b2 + kstep;
            PG8_LDB(B0, 0, 0); PG8_SCHED; PG8_LDA(At, 0, 0); PG8_STAGE(PG8_SA(1, 1), a1 + hsA, voffA);
            PG8_WAIT_V(6); PG8_WAIT_L(0); PG8_BAR; PG8_MMA(0, 0, At, B0); PG8_BAR; PG8_SCHED;
            PG8_LDA(At, 0, 1); PG8_STAGE(PG8_SB(0, 0), b2, voffB); PG8_STAGE(PG8_SA(0, 0), a2, voffA);
            PG8_WAIT_V(6); PG8_WAIT_L(0); PG8_BAR; PG8_MMA(1, 0, At, B0); PG8_BAR; PG8_SCHED;
            PG8_LDB(B0, 1, 0); PG8_SCHED; PG8_LDA(At, 1, 0); PG8_STAGE(PG8_SA(0, 1), a2 + hsA, voffA);
            PG8_WAIT_V(6); PG8_WAIT_L(0); PG8_BAR; PG8_MMA(0, 0, At, B0); PG8_BAR; PG8_SCHED;
            PG8_LDA(At, 1, 1); PG8_STAGE(PG8_SB(1, 0), b3, voffB); PG8_STAGE(PG8_SA(1, 0), a3, voffA);
            PG8_WAIT_V(6); PG8_WAIT_L(0); PG8_BAR; PG8_MMA(1, 0, At, B0); PG8_BAR; PG8_SCHED;
        }
        if (wr == 0) PG8_BAR;
        E(acc, cur, wr, wc, fr, fq);
        if (!has_next) break;
#pragma unroll
        for (int a = 0; a < 2; ++a)
#pragma unroll
            for (int b = 0; b < 1; ++b)
#pragma unroll
                for (int m = 0; m < 4; ++m)
#pragma unroll
                    for (int n = 0; n < 2; ++n) acc[a][b][m][n] = (f32x4){0.f, 0.f, 0.f, 0.f};
        cur = nxt; cA = nA; cB = nB; ++ui;
        if (wr == 1) PG8_BAR;
    }
    PG8_WAIT_V(0);
    PG8_BAR;
#undef PG8_SA
#undef PG8_SB
#undef PG8_STAGE
#undef PG8_LDA
#undef PG8_LDB
#undef PG8_MMA
#undef PG8_WAIT_V
#undef PG8_WAIT_L
#undef PG8_BAR
#undef PG8_SCHED
}

typedef f32x4 Acc[2][2][4][2];
struct EpiStore {
    bf16_t* O; unsigned ldc;
    DI void operator()(const Acc& acc, const Unit& u, int wr, int wc, int fr, int fq) const {
        asm volatile("" : "+v"(fr), "+v"(fq));
        const int row0 = u.pm * BM + wr * 64 + fr, col0 = u.pn * BM + wc * 32 + 8 * fq;
#pragma unroll
        for (int ai = 0; ai < 2; ++ai)
#pragma unroll
            for (int m = 0; m < 4; ++m) { bf16_t* rowp = O + (size_t)(row0 + ai * HALF + m * 16) * ldc + col0;
#pragma unroll
                for (int bj = 0; bj < 2; ++bj) { const f32x4 v0 = acc[ai][bj][m][0], v1 = acc[ai][bj][m][1];
                    u32x4 w; w.x = cvt_pk_bf16(v0[0], v0[1]); w.y = cvt_pk_bf16(v0[2], v0[3]); w.z = cvt_pk_bf16(v1[0], v1[1]); w.w = cvt_pk_bf16(v1[2], v1[3]);
                    *(u32x4*)(rowp + bj * HALF) = w; } }
    }
};
struct EpiSwiglu {
    bf16_t* O;
    DI void operator()(const Acc& acc, const Unit& u, int wr, int wc, int fr, int fq) const {
        asm volatile("" : "+v"(fr), "+v"(fq));
        const int row0 = u.pm * BM + wr * 64 + fr, col0 = u.pn * HALF + wc * 32 + 8 * fq;
#pragma unroll
        for (int ai = 0; ai < 2; ++ai)
#pragma unroll
            for (int m = 0; m < 4; ++m) { bf16_t* rowp = O + (size_t)(row0 + ai * HALF + m * 16) * FF + col0;
                float r[8];
#pragma unroll
                for (int n = 0; n < 2; ++n)
#pragma unroll
                    for (int j = 0; j < 4; ++j) { const float gv = acc[ai][0][m][n][j], uv = acc[ai][1][m][n][j]; r[n * 4 + j] = gv * __builtin_amdgcn_rcpf(1.f + __expf(-gv)) * uv; }
                u32x4 w; w.x = cvt_pk_bf16(r[0], r[1]); w.y = cvt_pk_bf16(r[2], r[3]); w.z = cvt_pk_bf16(r[4], r[5]); w.w = cvt_pk_bf16(r[6], r[7]);
                *(u32x4*)rowp = w; }
    }
};
template <bool IN32> DI f32x4 ld_h(const void* base, size_t off) {
    if constexpr (IN32) return *(const f32x4*)((const float*)base + off);
    else { const u32x2 w = *(const u32x2*)((const bf16_t*)base + off); return (f32x4){bflo(w.x), bfhi(w.x), bflo(w.y), bfhi(w.y)}; } }
template <bool OUT32> DI void st_h(void* base, size_t off, const f32x4 v) {
    if constexpr (OUT32) *(f32x4*)((float*)base + off) = v;
    else { u32x2 w; w.x = cvt_pk_bf16(v[0], v[1]); w.y = cvt_pk_bf16(v[2], v[3]); *(u32x2*)((bf16_t*)base + off) = w; } }
template <bool IN32, bool OUT32> struct EpiResid {
    const void* hin0; const void* hin1; void* hout; const float* gate; float coef;
    DI void operator()(const Acc& acc, const Unit& u, int wr, int wc, int fr, int fq) const {
        asm volatile("" : "+v"(fr), "+v"(fq));
        const int trow = u.pm * BM; const int cond = trow < T_CTX ? 0 : 1 + ((trow - T_CTX) >> 12);
        const size_t isz = IN32 ? 4 : 2, osz = OUT32 ? 4 : 2;
        const char* hin = trow < T_CTX ? (const char*)hin0 + (size_t)trow * DM * isz : (const char*)hin1 + (size_t)(trow - T_CTX) * DM * isz;
        char* ho = (char*)hout + (size_t)trow * DM * osz;
        const int r0 = wr * 64 + fr, col0 = u.pn * BM + wc * 32 + 4 * fq;
        const float* gp = gate + (size_t)cond * (NMOD * DM) + col0;
        f32x4 gv[2][2];
#pragma unroll
        for (int bj = 0; bj < 2; ++bj)
#pragma unroll
            for (int n = 0; n < 2; ++n) gv[bj][n] = *(const f32x4*)(gp + bj * HALF + n * 16) * coef;
#pragma unroll
        for (int ai = 0; ai < 2; ++ai)
#pragma unroll
            for (int m = 0; m < 4; ++m) { const size_t off = (size_t)(r0 + ai * HALF + m * 16) * DM + col0;
#pragma unroll
                for (int bj = 0; bj < 2; ++bj)
#pragma unroll
                    for (int n = 0; n < 2; ++n) { const f32x4 hv = ld_h<IN32>(hin, off + bj * HALF + n * 16);
                        st_h<OUT32>(ho, off + bj * HALF + n * 16, hv + gv[bj][n] * acc[ai][bj][m][n]); }
                asm volatile("" ::: "memory"); }
    }
};
typedef f32x4 AccH[2][1][4][2];
template <bool IN32, bool OUT32> struct EpiResidHN {
    const void* hin0; const void* hin1; void* hout; const float* gate; float coef;
    DI void operator()(const AccH& acc, const Unit& u, int wr, int wc, int fr, int fq) const {
        asm volatile("" : "+v"(fr), "+v"(fq));
        const int trow = u.pm * BM; const int cond = trow < T_CTX ? 0 : 1 + ((trow - T_CTX) >> 12);
        const size_t isz = IN32 ? 4 : 2, osz = OUT32 ? 4 : 2;
        const char* hin = trow < T_CTX ? (const char*)hin0 + (size_t)trow * DM * isz : (const char*)hin1 + (size_t)(trow - T_CTX) * DM * isz;
        char* ho = (char*)hout + (size_t)trow * DM * osz;
        const int r0 = wr * 64 + fr, col0 = u.pn * HALF + wc * 32 + 4 * fq;
        const float* gp = gate + (size_t)cond * (NMOD * DM) + col0;
        f32x4 gv[2];
#pragma unroll
        for (int n = 0; n < 2; ++n) gv[n] = *(const f32x4*)(gp + n * 16) * coef;
#pragma unroll
        for (int ai = 0; ai < 2; ++ai)
#pragma unroll
            for (int m = 0; m < 4; ++m) { const size_t off = (size_t)(r0 + ai * HALF + m * 16) * DM + col0;
#pragma unroll
                for (int n = 0; n < 2; ++n) { const f32x4 hv = ld_h<IN32>(hin, off + n * 16);
                    st_h<OUT32>(ho, off + n * 16, hv + gv[n] * acc[ai][0][m][n]); }
                asm volatile("" ::: "memory"); }
    }
};
struct EpiStoreHN {
    bf16_t* O0; unsigned ldc0; ptrdiff_t dO1; unsigned ldc1;
    DI void operator()(const AccH& acc, const Unit& u, int wr, int wc, int fr, int fq) const {
        asm volatile("" : "+v"(fr), "+v"(fq));
        const bool second = u.pn >= 256;
        bf16_t* O = (bf16_t*)((char*)O0 + (second ? dO1 : (ptrdiff_t)0)); const unsigned ldc = second ? ldc1 : ldc0;
        const int row0 = u.pm * BM + wr * 64 + fr, col0 = u.pn * HALF + wc * 32 + 8 * fq;
#pragma unroll
        for (int ai = 0; ai < 2; ++ai)
#pragma unroll
            for (int m = 0; m < 4; ++m) { bf16_t* rowp = O + (size_t)(row0 + ai * HALF + m * 16) * ldc + col0;
                const f32x4 v0 = acc[ai][0][m][0], v1 = acc[ai][0][m][1];
                u32x4 w; w.x = cvt_pk_bf16(v0[0], v0[1]); w.y = cvt_pk_bf16(v0[2], v0[3]); w.z = cvt_pk_bf16(v1[0], v1[1]); w.w = cvt_pk_bf16(v1[2], v1[3]);
                *(u32x4*)rowp = w; }
    }
};
struct SchedWinTail {
    const char* XN; const char* WIN; const char* WINF; int G, c;
    DI bool next(int i, Unit& u) const { const int L = i * G + c; if (L >= 198) return false;
        if (L < 70) { u.pm = 153 + L / 10; u.pn = L % 10; u.A = XN + (size_t)u.pm * BM * (DM * 2); u.B = WIN + (size_t)u.pn * HALF * (DM * 2); }
        else { const int t = L - 70; u.pm = t & 1; u.pn = 256 + (t >> 1); u.A = WINF + (size_t)u.pm * BM * (DM * 2); u.B = XN + (size_t)u.pn * HALF * (DM * 2); }
        return true; }
};
struct SchedHN {
    const char* A; const char* B; unsigned lda, ldb; int G, c;
    DI bool next(int i, Unit& u) const { const int L = i * G + c; if (L >= 256) return false; const int xcd = L & 7, slot = L >> 3;
        u.pm = 128 + xcd * 4 + (slot >> 3); u.pn = slot & 7;
        u.A = A + (size_t)u.pm * BM * lda; u.B = B + (size_t)u.pn * HALF * ldb; return true; }
};
struct EpiGlu {
    const bf16_t* YS; const float* bias; bf16_t* O;
    DI void operator()(const Acc& acc, const Unit& u, int wr, int wc, int fr, int fq) const {
        asm volatile("" : "+v"(fr), "+v"(fq));
        const int row0 = u.pm * BM + wr * 64 + fr, col0 = wc * 32 + 8 * fq;
#pragma unroll
        for (int ai = 0; ai < 2; ++ai)
#pragma unroll
            for (int m = 0; m < 4; ++m) { const int row = row0 + ai * HALF + m * 16;
#pragma unroll
                for (int bj = 0; bj < 2; ++bj) {
                    const f32x4 b0 = *(const f32x4*)(bias + col0 + bj * HALF), b1 = *(const f32x4*)(bias + col0 + bj * HALF + 4);
                    const u32x4 yv = *(const u32x4*)(YS + (size_t)row * 256 + col0 + bj * HALF);
                    const f32x4 v0 = acc[ai][bj][m][0] + b0, v1 = acc[ai][bj][m][1] + b1;
                    u32x4 w;
                    w.x = cvt_pk_bf16(bflo(yv.x) * sigmoid_f(v0[0]), bfhi(yv.x) * sigmoid_f(v0[1])); w.y = cvt_pk_bf16(bflo(yv.y) * sigmoid_f(v0[2]), bfhi(yv.y) * sigmoid_f(v0[3]));
                    w.z = cvt_pk_bf16(bflo(yv.z) * sigmoid_f(v1[0]), bfhi(yv.z) * sigmoid_f(v1[1])); w.w = cvt_pk_bf16(bflo(yv.w) * sigmoid_f(v1[2]), bfhi(yv.w) * sigmoid_f(v1[3]));
                    *(u32x4*)(O + (size_t)row * DM + col0 + bj * HALF) = w;
                    asm volatile("" ::: "memory"); } }
    }
};
struct EpiBias {
    const float* bias; bf16_t* O; int cbase;
    DI void operator()(const Acc& acc, const Unit& u, int wr, int wc, int fr, int fq) const {
        asm volatile("" : "+v"(fr), "+v"(fq));
        const int row0 = u.pm * BM + wr * 64 + fr, col0 = wc * 32 + 8 * fq;
#pragma unroll
        for (int ai = 0; ai < 2; ++ai)
#pragma unroll
            for (int m = 0; m < 4; ++m) { const int row = row0 + ai * HALF + m * 16;
#pragma unroll
                for (int bj = 0; bj < 2; ++bj) {
                    const f32x4 b0 = *(const f32x4*)(bias + col0 + bj * HALF), b1 = *(const f32x4*)(bias + col0 + bj * HALF + 4);
                    const f32x4 v0 = acc[ai][bj][m][0] + b0, v1 = acc[ai][bj][m][1] + b1;
                    u32x4 w; w.x = cvt_pk_bf16(v0[0], v0[1]); w.y = cvt_pk_bf16(v0[2], v0[3]); w.z = cvt_pk_bf16(v1[0], v1[1]); w.w = cvt_pk_bf16(v1[2], v1[3]);
                    *(u32x4*)(O + (size_t)row * DM + cbase + col0 + bj * HALF) = w;
                    asm volatile("" ::: "memory"); } }
    }
};
struct SchedDftLat {
    const char* TC; size_t dT; const char* PQT; int G, c;
    DI bool next(int i, Unit& u) const { const int L = i * G + c; if (L >= 256) return false; const int part = L & 3, mt = (L >> 2) & 7, b = L >> 5, cs = part >> 1, kh = part & 1;
        u.A = TC + (size_t)cs * dT + (size_t)(1 + 256 * mt) * 8192 + (size_t)kh * 4096; u.B = PQT + (size_t)cs * 256 * (T_ALL * 2) + (size_t)(T_CTX + b * 4096 + kh * 2048) * 2;
        u.pm = b * 8 + mt; u.pn = part; return true; }
};
struct SchedDftCtx {
    const char* TC; size_t dT; const char* PQT; int G, c;
    DI bool next(int i, Unit& u) const { const int L = i * G + (c + G / 4) % G; if (L >= 64) return false; const int half = L & 1, b = L >> 1;
        u.A = TC + (size_t)half * dT; u.B = PQT + (size_t)half * 256 * (T_ALL * 2) + (size_t)(b * 256) * 2;
        u.pm = b; u.pn = half; return true; }
};
struct EpiDftSym {
    bf16_t* O;
    DI void operator()(const Acc& acc, const Unit& u, int wr, int wc, int fr, int fq) const {
        asm volatile("" : "+v"(fr), "+v"(fq));
        const int b = u.pm >> 3, mt = u.pm & 7, part = u.pn; const unsigned sgn = (part >> 1) ? 0x80008000u : 0u;
        bf16_t* base = O + (size_t)(T_CTX + b * 4096) * 1024 + part * 256 + wc * 32 + 8 * fq;
        const int lp0 = 1 + 256 * mt + wr * 64 + fr;
#pragma unroll
        for (int ai = 0; ai < 2; ++ai)
#pragma unroll
            for (int m = 0; m < 4; ++m) { const int lp = lp0 + ai * HALF + m * 16;
#pragma unroll
                for (int bj = 0; bj < 2; ++bj) { const f32x4 v0 = acc[ai][bj][m][0], v1 = acc[ai][bj][m][1];
                    u32x4 w; w.x = cvt_pk_bf16(v0[0], v0[1]); w.y = cvt_pk_bf16(v0[2], v0[3]); w.z = cvt_pk_bf16(v1[0], v1[1]); w.w = cvt_pk_bf16(v1[2], v1[3]);
                    *(u32x4*)(base + (unsigned)(lp * 1024 + bj * HALF)) = w;
                    w.x ^= sgn; w.y ^= sgn; w.z ^= sgn; w.w ^= sgn;
                    *(u32x4*)(base + (unsigned)((4096 - lp) * 1024 + bj * HALF)) = w;
                    asm volatile("" ::: "memory"); } }
    }
};
struct EpiDftCtx {
    bf16_t* O;
    DI void operator()(const Acc& acc, const Unit& u, int wr, int wc, int fr, int fq) const {
        asm volatile("" : "+v"(fr), "+v"(fq));
        const int row0 = u.pm * BM + wr * 64 + fr, col0 = u.pn * 512 + wc * 32 + 8 * fq;
#pragma unroll
        for (int ai = 0; ai < 2; ++ai)
#pragma unroll
            for (int m = 0; m < 4; ++m) { bf16_t* rowp = O + (size_t)(row0 + ai * HALF + m * 16) * 1024 + col0;
#pragma unroll
                for (int bj = 0; bj < 2; ++bj) { const f32x4 v0 = acc[ai][bj][m][0], v1 = acc[ai][bj][m][1];
                    u32x4 w; w.x = cvt_pk_bf16(v0[0], v0[1]); w.y = cvt_pk_bf16(v0[2], v0[3]); w.z = cvt_pk_bf16(v1[0], v1[1]); w.w = cvt_pk_bf16(v1[2], v1[3]);
                    *(u32x4*)(rowp + bj * HALF) = w; *(u32x4*)(rowp + 256 + bj * HALF) = (u32x4){0u, 0u, 0u, 0u}; } }
    }
};
}

constexpr int PTAB_OFF = 131072;
struct InTab { const unsigned char* lds;
    DI const float* operator[](int k) const { const u32x2 v = *(const u32x2*)(lds + PTAB_OFF + 8 * k);
        const unsigned long long p = ((unsigned long long)(unsigned)__builtin_amdgcn_readfirstlane((int)v.y) << 32) | (unsigned)__builtin_amdgcn_readfirstlane((int)v.x); return (const float*)(const __attribute__((address_space(1))) float*)p; } };
struct Frame {
    unsigned char* lds; LAS unsigned char* ldsl;
    int tid, lane, wave, G, bid;
    InTab in; float* out; unsigned char* ws;
};
DI Frame mkframe(unsigned char* lds, int wv) {
    Frame F; F.lds = lds; F.ldsl = (LAS unsigned char*)lds;
    asm volatile("" : "+s"(wv));
    unsigned z = 0u; asm volatile("v_mov_b32 %0, 0" : "=v"(z));
    int tid = wv * 64 + (int)__builtin_amdgcn_mbcnt_hi(~0u, __builtin_amdgcn_mbcnt_lo(~0u, z)); asm volatile("" : "+v"(tid));
    F.tid = tid; F.lane = tid & 63; F.wave = __builtin_amdgcn_readfirstlane(tid >> 6);
    int g = gridDim.x, b = blockIdx.x; asm volatile("" : "+s"(g), "+s"(b)); F.G = g; F.bid = b;
    F.in.lds = lds; F.out = (float*)F.in[36]; F.ws = (unsigned char*)F.in[37];
    return F;
}


#define XB_TMO      128
#define XB_XCNT(j)  (256  + 64 * (j))
#define XB_XSUB(j)  (1280 + 64 * (j))
#define XB_XGEN(j)  (2304 + 64 * (j))
#define XB_TOP      3328
#define XB_TOPGEN   3392
#define XB_SPIN_CAP (1u << 20)
constexpr int XBST_OFF = PTAB_OFF + 512;
DI unsigned xb_ld(unsigned* p)              { return __hip_atomic_load(p, __ATOMIC_RELAXED, __HIP_MEMORY_SCOPE_AGENT); }
DI unsigned xb_add(unsigned* p, unsigned v) { return __hip_atomic_fetch_add(p, v, __ATOMIC_RELAXED, __HIP_MEMORY_SCOPE_AGENT); }
DI unsigned xb_xcc_id() { return (unsigned)__builtin_amdgcn_s_getreg((3 << 11) | 20) & 0xFu; }
#define XB_SPIN(cond, bar) do { unsigned _sp = 0; while (cond) { __builtin_amdgcn_s_sleep(1); \
    if ((++_sp & 255u) == 0u) { if (xb_ld(&(bar)[XB_TMO])) break; if (_sp > XB_SPIN_CAP) { atomicAdd(&(bar)[XB_TMO], 1u); break; } } } } while (0)
DI void xcd_barrier_complete(unsigned* bar, unsigned x, unsigned& nloc, unsigned& nx) {
    const unsigned G = gridDim.x;
    unsigned sum, cnt, mine, sp = 0u;
    for (;;) {
        sum = 0u; cnt = 0u; mine = 0u;
#pragma unroll
        for (unsigned j = 0; j < 16; ++j) { const unsigned c = xb_ld(&bar[XB_XCNT(j)]); sum += c; cnt += (c > 0u) ? 1u : 0u; mine = (j == x) ? c : mine; }
        if (sum == G) break;
        __builtin_amdgcn_s_sleep(1);
        if ((++sp & 255u) == 0u) { if (xb_ld(&bar[XB_TMO])) break; if (sp > XB_SPIN_CAP) { atomicAdd(&bar[XB_TMO], 1u); break; } }
    }
    nloc = mine > 0u ? mine : 1u; nx = cnt > 0u ? cnt : 1u;
}
DI void xcd_sync(unsigned char* lds, int wv) {
    asm volatile("s_waitcnt vmcnt(0) lgkmcnt(0)" ::: "memory");
    __syncthreads();
    asm volatile("" : "+s"(wv));
    if (wv == 0) {
        unsigned z = 0u; asm volatile("v_mov_b32 %0, 0" : "=v"(z));
        const unsigned lane = __builtin_amdgcn_mbcnt_hi(~0u, __builtin_amdgcn_mbcnt_lo(~0u, z));
        if (lane == 0) {
            InTab in; in.lds = lds; unsigned* bar = (unsigned*)((unsigned char*)in[37] + OFF_CTL);
            volatile unsigned* st = (volatile unsigned*)(lds + XBST_OFF);
            const unsigned x = xb_xcc_id();
            __builtin_amdgcn_s_waitcnt(0);
            unsigned nloc = st[0], nx = st[1];
            if (nloc == 0u) { xcd_barrier_complete(bar, x, nloc, nx); st[0] = nloc; st[1] = nx; }
            const unsigned old = xb_add(&bar[XB_XSUB(x)], 1u);
            const unsigned gen = old / nloc;
            if (old + 1u == (gen + 1u) * nloc) {
                __builtin_amdgcn_fence(__ATOMIC_RELEASE, "agent");
                asm volatile("s_waitcnt vmcnt(0)" ::: "memory");
                const unsigned og = xb_add(&bar[XB_TOP], 1u);
                const unsigned tg = og / nx;
                if (og + 1u == (tg + 1u) * nx) xb_add(&bar[XB_TOPGEN], 1u);
                else XB_SPIN(xb_ld(&bar[XB_TOPGEN]) == tg, bar);
                __builtin_amdgcn_fence(__ATOMIC_ACQUIRE, "agent");
                xb_add(&bar[XB_XGEN(x)], 1u);
                asm volatile("s_waitcnt vmcnt(0)" ::: "memory");
            } else {
                XB_SPIN(xb_ld(&bar[XB_XGEN(x)]) == gen, bar);
                __builtin_amdgcn_fence(__ATOMIC_ACQUIRE, "agent");
                asm volatile("s_waitcnt vmcnt(0)" ::: "memory");
            }
        }
    }
    __syncthreads();
}

DI void transpose_item(const float* W, int ldw, int k0, int n0, bf16_t* WT, int ldt, int drow0, int dk0, int dk1, float* scr, int lane) {
    { float tv[32];
#pragma unroll
      for (int i = 0; i < 32; ++i) tv[i] = W[(size_t)(k0 + 2 * i + (lane >> 5)) * ldw + n0 + (lane & 31)];
#pragma unroll
      for (int i = 0; i < 32; ++i) scr[(2 * i + (lane >> 5)) * 33 + (lane & 31)] = tv[i]; }
    asm volatile("" ::: "memory"); __builtin_amdgcn_wave_barrier(); asm volatile("" ::: "memory"); asm volatile("s_waitcnt lgkmcnt(0)" ::: "memory");
    const int c = lane & 7;
#pragma unroll
    for (int j = 0; j < 4; ++j) { const int n = (lane >> 3) + 8 * j; const float* s = scr + (8 * c) * 33 + n;
        u32x4 o; o.x = cvt_pk_bf16(s[0 * 33], s[1 * 33]); o.y = cvt_pk_bf16(s[2 * 33], s[3 * 33]); o.z = cvt_pk_bf16(s[4 * 33], s[5 * 33]); o.w = cvt_pk_bf16(s[6 * 33], s[7 * 33]);
        *(u32x4*)(WT + (size_t)(drow0 + n) * ldt + dk0 + 8 * c) = o;
        if (dk1 >= 0) *(u32x4*)(WT + (size_t)(drow0 + n) * ldt + dk1 + 8 * c) = o; }
    asm volatile("" ::: "memory"); __builtin_amdgcn_wave_barrier(); asm volatile("" ::: "memory"); asm volatile("s_waitcnt lgkmcnt(0)" ::: "memory");
}

DI void p0_phase(unsigned char* lds_, int wv_) {
    Frame F = mkframe(lds_, wv_);
    const int gw = F.bid * NWAVES + F.wave, NGW = F.G * NWAVES;
    {
        float* scr = (float*)(F.lds + F.wave * 8704);
        constexpr int PER_L = 6 * 1408 + 640 + 512 + 32 + 32;
        for (int it = gw; it < 2 * PER_L; it += NGW) {
            const int l = it / PER_L; int r = it % PER_L;
            if (r < 6 * 1408) { const int j = r / 1408, q = r % 1408, f = j / 3, t = j % 3;
                const float* W = F.in[12 + j] + (size_t)l * DM * FF;
                if (t < 2) { const int kb = q / 88, nb = q % 88, n0 = 32 * nb;
                    transpose_item(W, FF, 64 * kb, n0, (bf16_t*)(F.ws + OFF_WGU + (size_t)(l * 2 + f) * SZ_WGU), DM, (n0 >> 7) * 256 + (n0 & 127) + (t ? 128 : 0), 64 * kb, -1, scr, F.lane); }
                else { const int kb = q / 32, nb = q % 32;
                    transpose_item(W, DM, 64 * kb, 32 * nb, (bf16_t*)(F.ws + OFF_WDN + (size_t)(l * 2 + f) * SZ_WDN), FF, 32 * nb, 64 * kb, -1, scr, F.lane); }
                continue; }
            r -= 6 * 1408;
            if (r < 640) { const int kb = r / 40, nb = r % 40;
                transpose_item(F.in[18] + (size_t)l * DM * 1536, 1536, 64 * kb, 32 * nb, (bf16_t*)(F.ws + OFF_WIN + (size_t)l * NPROJ * DM * 2), DM, 32 * nb, 64 * kb, -1, scr, F.lane); continue; }
            r -= 640;
            if (r < 512) { const int kb = r / 32, nb = r % 32;
                transpose_item(F.in[19] + (size_t)l * DM * DM, DM, 64 * kb, 32 * nb, (bf16_t*)(F.ws + OFF_WOUT + (size_t)l * DM * DM * 2), DM, 32 * nb, 64 * kb, -1, scr, F.lane); continue; }
            r -= 512;
            if (r < 32) { const int kb = r / 8, nb = r % 8;
                transpose_item(F.in[28] + (size_t)l * 65536, 256, 64 * kb, 32 * nb, (bf16_t*)(F.ws + OFF_WGLU + (size_t)l * 65536 * 2), 256, 32 * nb, 64 * kb, -1, scr, F.lane); continue; }
            r -= 32;
            { const int kb = r / 8, nb = r % 8;
                transpose_item(F.in[33] + (size_t)l * 65536, 256, 64 * kb, 32 * nb, (bf16_t*)(F.ws + OFF_WFN + (size_t)l * 256 * 1024 * 2), 1024, 32 * nb, 64 * kb, 64 * kb + 256, scr, F.lane);
                transpose_item(F.in[33] + (size_t)l * 65536, 256, 64 * kb, 32 * nb, (bf16_t*)(F.ws + OFF_WFN + (size_t)l * 256 * 1024 * 2), 1024, 32 * nb, 64 * kb + 512, 64 * kb + 768, scr, F.lane); }
        }
    }
    __syncthreads();
    float* tab = (float*)(F.lds);
    for (int j = F.tid; j < 4096; j += NTHREADS) tab[j] = cospif((float)j * (1.0f / 2048.0f));
    __syncthreads();
    {
        bf16_t* TC4 = (bf16_t*)(F.ws + OFF_TC4); bf16_t* TS4 = (bf16_t*)(F.ws + OFF_TS4);
        for (int rr = F.bid; rr < 2049; rr += F.G) {
            const int l0 = 8 * F.tid; float cv[8], sv[8];
#pragma unroll
            for (int j = 0; j < 8; ++j) { const int idx = (rr * (l0 + j)) & 4095; cv[j] = tab[idx] * (1.f / 64.f); sv[j] = -tab[(idx - 1024) & 4095] * (1.f / 64.f); }
            u32x4 a, b; a.x = cvt_pk_bf16(cv[0], cv[1]); a.y = cvt_pk_bf16(cv[2], cv[3]); a.z = cvt_pk_bf16(cv[4], cv[5]); a.w = cvt_pk_bf16(cv[6], cv[7]);
            b.x = cvt_pk_bf16(sv[0], sv[1]); b.y = cvt_pk_bf16(sv[2], sv[3]); b.z = cvt_pk_bf16(sv[4], sv[5]); b.w = cvt_pk_bf16(sv[6], sv[7]);
            *(u32x4*)(TC4 + (size_t)rr * 4096 + l0) = a; *(u32x4*)(TS4 + (size_t)rr * 4096 + l0) = b;
        }
        bf16_t* TC2 = (bf16_t*)(F.ws + OFF_TC2); bf16_t* TS2 = (bf16_t*)(F.ws + OFF_TS2);
        for (int rr = F.bid; rr < 256; rr += F.G) if (F.tid < 32) {
            const int l0 = 8 * F.tid; float cv[8], sv[8];
#pragma unroll
            for (int j = 0; j < 8; ++j) { const int idx = ((rr * (l0 + j)) & 255) * 16; cv[j] = tab[idx] * (1.f / 16.f); sv[j] = -tab[(idx - 1024) & 4095] * (1.f / 16.f); }
            u32x4 a, b; a.x = cvt_pk_bf16(cv[0], cv[1]); a.y = cvt_pk_bf16(cv[2], cv[3]); a.z = cvt_pk_bf16(cv[4], cv[5]); a.w = cvt_pk_bf16(cv[6], cv[7]);
            b.x = cvt_pk_bf16(sv[0], sv[1]); b.y = cvt_pk_bf16(sv[2], sv[3]); b.z = cvt_pk_bf16(sv[4], sv[5]); b.w = cvt_pk_bf16(sv[6], sv[7]);
            *(u32x4*)(TC2 + (size_t)rr * 256 + l0) = a; *(u32x4*)(TS2 + (size_t)rr * 256 + l0) = b;
        }
    }
    {
        float* wrow = (float*)(F.lds + 16384);
        for (int u = F.bid; u < 256; u += F.G) {
            const int l = u >> 7, k0 = 8 * (u & 127);
            __syncthreads();
            for (int e = F.tid; e < 2048; e += NTHREADS) wrow[e] = F.in[18][(size_t)l * DM * 1536 + (size_t)(k0 + (e >> 8)) * 1536 + 1280 + (e & 255)];
            __syncthreads();
            const int n2 = F.tid, nn = n2 & 255, sh = (n2 >= 256) ? 1024 : 0;
            float a[8] = {0.f, 0.f, 0.f, 0.f, 0.f, 0.f, 0.f, 0.f};
            for (int c = 0; c < 256; ++c) { const float t = tab[((((c * nn) & 255) << 4) - sh) & 4095];
#pragma unroll
                for (int r = 0; r < 8; ++r) a[r] += wrow[r * 256 + c] * t; }
            u32x4 o; o.x = cvt_pk_bf16(a[0] * 0.0625f, a[1] * 0.0625f); o.y = cvt_pk_bf16(a[2] * 0.0625f, a[3] * 0.0625f); o.z = cvt_pk_bf16(a[4] * 0.0625f, a[5] * 0.0625f); o.w = cvt_pk_bf16(a[6] * 0.0625f, a[7] * 0.0625f);
            *(u32x4*)((bf16_t*)(F.ws + OFF_WINF) + (size_t)l * 512 * DM + (size_t)n2 * DM + k0) = o;
        }
    }
    __syncthreads();
    {
        float* sc = (float*)(F.lds);
        float* red = (float*)(F.lds + 40960);
        for (int e = F.tid; e < 9 * 1024; e += NTHREADS) { const int i = e >> 10, k = e & 1023; const float v = (i == 0) ? F.in[6][k] : F.in[5][(size_t)(i - 1) * DM + k]; sc[e] = silu_f(v); }
        __syncthreads();
        for (int u = F.bid; u < 288; u += F.G) {
            const int l = u / 144, j0 = 64 * (u % 144), jc = F.tid & 63, kg = F.tid >> 6;
            const float* W = F.in[7] + (size_t)l * DM * 9216 + j0 + jc;
            float a[9] = {0.f, 0.f, 0.f, 0.f, 0.f, 0.f, 0.f, 0.f, 0.f};
            for (int k0 = kg * 128; k0 < kg * 128 + 128; k0 += 16) { float wv[16];
#pragma unroll
                for (int q = 0; q < 16; ++q) wv[q] = W[(size_t)(k0 + q) * 9216];
#pragma unroll
                for (int q = 0; q < 16; ++q) {
#pragma unroll
                    for (int i = 0; i < 9; ++i) a[i] += sc[i * 1024 + k0 + q] * wv[q]; } }
#pragma unroll
            for (int i = 0; i < 9; ++i) red[(kg * 9 + i) * 64 + jc] = a[i];
            __syncthreads();
            for (int o = F.tid; o < 576; o += NTHREADS) { const int i = o >> 6, jj = o & 63; float s = 0.f;
#pragma unroll
                for (int q = 0; q < 8; ++q) s += red[(q * 9 + i) * 64 + jj];
                ((float*)(F.ws + OFF_MOD))[(size_t)(l * 9 + i) * 9216 + j0 + jj] = s + F.in[8][(size_t)l * 9216 + j0 + jj]; }
            __syncthreads();
        }
    }
    {
        const size_t gt = (size_t)F.bid * NTHREADS + F.tid, GT = (size_t)F.G * NTHREADS;
        for (size_t e = gt; e < (size_t)2 * 2 * 8 * 2 * 4096; e += GT) {
            const int ch = (int)(e & 4095); size_t r = e >> 12; const int kv = r & 1; r >>= 1; const int b = r & 7; r >>= 3; const int g = r & 1; const int l = (int)(r >> 1);
            const float* src = F.in[2 + g] + ((((size_t)b * 2 + l) * 2 + kv) * 32768) + (size_t)ch * 8;
            const f32x4 v0 = *(const f32x4*)src, v1 = *(const f32x4*)(src + 4);
            u32x4 o; o.x = cvt_pk_bf16(v0[0], v0[1]); o.y = cvt_pk_bf16(v0[2], v0[3]); o.z = cvt_pk_bf16(v1[0], v1[1]); o.w = cvt_pk_bf16(v1[2], v1[3]);
            *(u32x4*)((bf16_t*)(F.ws + OFF_CKV) + e * 8) = o;
        }
        for (size_t e = gt; e < (size_t)4096 * 32; e += GT) { const int pos = (int)(e >> 5), i = (int)(e & 31), f = i & 15;
            const float inv = powf(10000.0f, -(float)f * (1.0f / 16.0f)); const float ang = (float)(i < 16 ? (pos >> 6) : (pos & 63)) * inv;
            ((f32x2*)(F.ws + OFF_ROPE))[e] = (f32x2){cosf(ang), sinf(ang)}; }
        for (size_t e = (size_t)((F.bid + F.G / 2) % F.G) * NTHREADS + F.tid; e < (size_t)2 * 2 * 16 * 64 * 8; e += GT) {
            const int sb = (int)(e & 7), p = (int)((e >> 3) & 63), g = (int)((e >> 9) & 15), dir = (int)((e >> 13) & 1), l = (int)(e >> 14);
            const int pi = ((l * 2 + dir) * 16 + g) * 64 + p;
            const float lre = F.in[20][pi], lim = F.in[21][pi], dt = __expf(F.in[26][(l * 2 + dir) * 16 + g]);
            const float er = expf(lre * dt); float sn, cs; sincosf(lim * dt, &sn, &cs);
            const float ar = er * cs, ai = er * sn, nr = ar - 1.f, ni = ai, dd = 1.f / (lre * lre + lim * lim);
            const float qr = (nr * lre + ni * lim) * dd, qi = (ni * lre - nr * lim) * dd;
            float br[16], bi[16];
#pragma unroll
            for (int c4 = 0; c4 < 4; ++c4) { const f32x4 r = *(const f32x4*)(F.in[22] + (size_t)pi * 16 + 4 * c4), m = *(const f32x4*)(F.in[23] + (size_t)pi * 16 + 4 * c4);
#pragma unroll
                for (int j = 0; j < 4; ++j) { br[4 * c4 + j] = qr * r[j] - qi * m[j]; bi[4 * c4 + j] = qr * m[j] + qi * r[j]; } }
            bf16_t* wre = (bf16_t*)(F.ws + OFF_W128) + ((size_t)pi * 2) * 2048; bf16_t* wim = wre + 2048;
            for (int s_ = sb * 16; s_ < sb * 16 + 16; ++s_) {
                const float kk = (float)(dir ? s_ : 127 - s_); const float pe = expf(kk * lre * dt); float ps, pc; sincosf(kk * lim * dt, &ps, &pc);
                const float pr = pe * pc, pim = pe * ps;
                u32x4 a0, a1, b0, b1;
                a0.x = cvt_pk_bf16(pr * br[0] - pim * bi[0], pr * br[1] - pim * bi[1]); a0.y = cvt_pk_bf16(pr * br[2] - pim * bi[2], pr * br[3] - pim * bi[3]);
                a0.z = cvt_pk_bf16(pr * br[4] - pim * bi[4], pr * br[5] - pim * bi[5]); a0.w = cvt_pk_bf16(pr * br[6] - pim * bi[6], pr * br[7] - pim * bi[7]);
                a1.x = cvt_pk_bf16(pr * br[8] - pim * bi[8], pr * br[9] - pim * bi[9]); a1.y = cvt_pk_bf16(pr * br[10] - pim * bi[10], pr * br[11] - pim * bi[11]);
                a1.z = cvt_pk_bf16(pr * br[12] - pim * bi[12], pr * br[13] - pim * bi[13]); a1.w = cvt_pk_bf16(pr * br[14] - pim * bi[14], pr * br[15] - pim * bi[15]);
                b0.x = cvt_pk_bf16(pr * bi[0] + pim * br[0], pr * bi[1] + pim * br[1]); b0.y = cvt_pk_bf16(pr * bi[2] + pim * br[2], pr * bi[3] + pim * br[3]);
                b0.z = cvt_pk_bf16(pr * bi[4] + pim * br[4], pr * bi[5] + pim * br[5]); b0.w = cvt_pk_bf16(pr * bi[6] + pim * br[6], pr * bi[7] + pim * br[7]);
                b1.x = cvt_pk_bf16(pr * bi[8] + pim * br[8], pr * bi[9] + pim * br[9]); b1.y = cvt_pk_bf16(pr * bi[10] + pim * br[10], pr * bi[11] + pim * br[11]);
                b1.z = cvt_pk_bf16(pr * bi[12] + pim * br[12], pr * bi[13] + pim * br[13]); b1.w = cvt_pk_bf16(pr * bi[14] + pim * br[14], pr * bi[15] + pim * br[15]);
                *(u32x4*)(wre + 16 * s_) = a0; *(u32x4*)(wre + 16 * s_ + 8) = a1; *(u32x4*)(wim + 16 * s_) = b0; *(u32x4*)(wim + 16 * s_ + 8) = b1;
            }
        }
    }
}

DI void norm_phase(unsigned char* lds_, int wv_, int l, int which, bool first) {
    Frame F = mkframe(lds_, wv_);
    const float* h0 = F.in[0]; const float* h1 = F.in[1]; const bf16_t* HB = (const bf16_t*)(F.ws + OFF_HB);
    const float* gvec = F.in[which == 0 ? 9 : which == 1 ? 10 : 11] + l * DM; const float* modl = (const float*)(F.ws + OFF_MOD) + (size_t)l * 9 * 9216; const int jsh = which * 3, jsc = which * 3 + 1;
    const int gw = F.bid * NWAVES + F.wave, NGW = F.G * NWAVES;
    bf16_t* XN = (bf16_t*)(F.out);
    f32x4 gv[4];
#pragma unroll
    for (int j = 0; j < 4; ++j) gv[j] = *(const f32x4*)(gvec + 4 * F.lane + 256 * j);
    for (int row0 = gw * 4; row0 < T_ALL; row0 += NGW * 4) {
        f32x4 v[4][4]; float s[4];
#pragma unroll
        for (int r = 0; r < 4; ++r) { const int row = row0 + r;
            if (first) { const float* src = row < T_CTX ? h0 + (size_t)row * DM : h1 + (size_t)(row - T_CTX) * DM;
#pragma unroll
                for (int j = 0; j < 4; ++j) v[r][j] = *(const f32x4*)(src + 4 * F.lane + 256 * j); }
            else {
#pragma unroll
                for (int j = 0; j < 4; ++j) { const u32x2 w = *(const u32x2*)(HB + (size_t)row * DM + 4 * F.lane + 256 * j); v[r][j] = (f32x4){bflo(w.x), bfhi(w.x), bflo(w.y), bfhi(w.y)}; } } }
#pragma unroll
        for (int r = 0; r < 4; ++r) { float a = 0.f;
#pragma unroll
            for (int j = 0; j < 4; ++j) a += (v[r][j].x * v[r][j].x + v[r][j].y * v[r][j].y) + (v[r][j].z * v[r][j].z + v[r][j].w * v[r][j].w);
            s[r] = a; }
#pragma unroll
        for (int o = 1; o < 64; o <<= 1) {
#pragma unroll
            for (int r = 0; r < 4; ++r) s[r] += shx(s[r], o, F.lane); }
#pragma unroll
        for (int r = 0; r < 4; ++r) { const int row = row0 + r;
            const int cond = row < T_CTX ? 0 : 1 + ((row - T_CTX) >> 12);
            const float* shp = modl + (size_t)cond * 9216 + jsh * 1024; const float* scp = modl + (size_t)cond * 9216 + jsc * 1024;
            const float rstd = rsqrtf(s[r] * (1.f / DM) + EPSF);
#pragma unroll
            for (int j = 0; j < 4; ++j) { const f32x4 sh = *(const f32x4*)(shp + 4 * F.lane + 256 * j), sc = *(const f32x4*)(scp + 4 * F.lane + 256 * j);
                const f32x4 o = (v[r][j] * rstd * gv[j]) * (sc + 1.f) + sh;
                u32x2 w; w.x = cvt_pk_bf16(o.x, o.y); w.y = cvt_pk_bf16(o.z, o.w);
                *(u32x2*)(XN + (size_t)row * DM + 4 * F.lane + 256 * j) = w; } }
    }
}
DI void final_norm_phase(unsigned char* lds_, int wv_) {
    Frame F = mkframe(lds_, wv_);
    const int gw = F.bid * NWAVES + F.wave, NGW = F.G * NWAVES;
    f32x4 gv[4];
#pragma unroll
    for (int j = 0; j < 4; ++j) gv[j] = *(const f32x4*)(F.in[35] + 4 * F.lane + 256 * j);
    for (int row0 = gw * 4; row0 < T_ALL; row0 += NGW * 4) {
        f32x4 v[4][4]; float s[4];
#pragma unroll
        for (int r = 0; r < 4; ++r) { const float* p = F.out + (size_t)(row0 + r) * DM;
#pragma unroll
            for (int j = 0; j < 4; ++j) v[r][j] = *(const f32x4*)(p + 4 * F.lane + 256 * j); }
#pragma unroll
        for (int r = 0; r < 4; ++r) { float a = 0.f;
#pragma unroll
            for (int j = 0; j < 4; ++j) a += (v[r][j].x * v[r][j].x + v[r][j].y * v[r][j].y) + (v[r][j].z * v[r][j].z + v[r][j].w * v[r][j].w);
            s[r] = a; }
#pragma unroll
        for (int o = 1; o < 64; o <<= 1) {
#pragma unroll
            for (int r = 0; r < 4; ++r) s[r] += shx(s[r], o, F.lane); }
#pragma unroll
        for (int r = 0; r < 4; ++r) { float* p = F.out + (size_t)(row0 + r) * DM; const float rstd = rsqrtf(s[r] * (1.f / DM) + EPSF);
#pragma unroll
            for (int j = 0; j < 4; ++j) __builtin_nontemporal_store(v[r][j] * rstd * gv[j], (f32x4*)(p + 4 * F.lane + 256 * j)); }
    }
}

DI void kprep_phase(unsigned char* lds_, int wv_, int l) {
    Frame F = mkframe(lds_, wv_);
    const int gw = F.bid * NWAVES + F.wave, NGW = F.G * NWAVES;
    const bf16_t* PROJ = (const bf16_t*)(F.ws + OFF_PROJ); bf16_t* KR = (bf16_t*)(F.ws + OFF_KR);
    const f32x2* ROPE = (const f32x2*)(F.ws + OFF_ROPE);
    const int hk = F.lane >> 5, i = F.lane & 31;
    const float gk0 = F.in[32][l * 64 + i], gk1 = F.in[32][l * 64 + i + 32];
    bf16_t n0 = 0, n1 = 0, n2 = 0, n3 = 0;
    if (gw < T_ALL) { const bf16_t* p0 = PROJ + (size_t)gw * NPROJ; n0 = p0[512 + hk * 64 + i]; n1 = p0[512 + hk * 64 + i + 32]; n2 = p0[1024 + hk * 64 + i]; n3 = p0[1024 + hk * 64 + i + 32]; }
    for (int tok = gw; tok < T_ALL; tok += NGW) {
        const bf16_t* pr = PROJ + (size_t)tok * NPROJ;
        float s1 = bf1(n0), s2 = bf1(n1);
        float a1 = bf1(n2), a2 = bf1(n3);
        if (tok + NGW < T_ALL) { const bf16_t* pn = pr + (size_t)NGW * NPROJ; n0 = pn[512 + hk * 64 + i]; n1 = pn[512 + hk * 64 + i + 32]; n2 = pn[1024 + hk * 64 + i]; n3 = pn[1024 + hk * 64 + i + 32]; }
        float ss = a1 * a1 + a2 * a2;
#pragma unroll
        for (int o = 1; o < 32; o <<= 1) ss += shx(ss, o, F.lane);
        const float rn = rsqrtf(ss * (1.f / 64.f) + EPSF);
        a1 = a1 * rn * gk0; a2 = a2 * rn * gk1;
        if (tok >= T_CTX) {
            const int pos = (tok - T_CTX) & 4095; const f32x2 cs = ROPE[pos * 32 + i];
            const float r1 = s1 * cs.x - s2 * cs.y, r2 = s2 * cs.x + s1 * cs.y; s1 = r1; s2 = r2;
            const float q1 = a1 * cs.x - a2 * cs.y, q2 = a2 * cs.x + a1 * cs.y; a1 = q1; a2 = q2;
        } else {
            const int b = tok >> 8, t = tok & 255;
            float* os = F.out + OUT_SWA + ((((size_t)b * 2 + l) * 2 + 0) * 256 + t) * 128;
            float* oa = F.out + OUT_AX + ((((size_t)b * 2 + l) * 2 + 0) * 256 + t) * 128;
            os[hk * 64 + i] = s1; os[hk * 64 + i + 32] = s2; oa[hk * 64 + i] = a1; oa[hk * 64 + i + 32] = a2;
            const unsigned vs = *(const unsigned*)(pr + 640 + 2 * F.lane), va = *(const unsigned*)(pr + 1152 + 2 * F.lane);
            *(f32x2*)(os + 32768 + 2 * F.lane) = (f32x2){bflo(vs), bfhi(vs)};
            *(f32x2*)(oa + 32768 + 2 * F.lane) = (f32x2){bflo(va), bfhi(va)};
        }
        bf16_t* kr = KR + (size_t)tok * 256;
        kr[hk * 64 + i] = (bf16_t)f2bf(s1); kr[hk * 64 + i + 32] = (bf16_t)f2bf(s2);
        kr[128 + hk * 64 + i] = (bf16_t)f2bf(a1); kr[128 + hk * 64 + i + 32] = (bf16_t)f2bf(a2);
    }
}

constexpr int S5_TC = 128, S5_LDS_PER_WAVE = 13824;
struct S5Dir { f32x2 a, aT; f32x2 b[16]; };
DI void s5_load_dir(Frame& F, int l, int dir, int g, int p, S5Dir& d) {
    const int pi = ((l * 2 + dir) * 16 + g) * 64 + p;
    const float lre = F.in[20][pi], lim = F.in[21][pi], dt = __expf(F.in[26][(l * 2 + dir) * 16 + g]);
    const float er = expf(lre * dt); float sn, cs; sincosf(lim * dt, &sn, &cs);
    const float ar = er * cs, ai = er * sn;
    d.a = (f32x2){ar, ai};
    const float nr = ar - 1.f, ni = ai, dd = 1.f / (lre * lre + lim * lim);
    const float qr = (nr * lre + ni * lim) * dd, qi = (ni * lre - nr * lim) * dd;
    const float* bre = F.in[22] + (size_t)pi * 16; const float* bim = F.in[23] + (size_t)pi * 16;
#pragma unroll
    for (int c4 = 0; c4 < 4; ++c4) { const f32x4 r = *(const f32x4*)(bre + 4 * c4), m = *(const f32x4*)(bim + 4 * c4);
#pragma unroll
        for (int j = 0; j < 4; ++j) d.b[4 * c4 + j] = (f32x2){qr * r[j] - qi * m[j], qr * m[j] + qi * r[j]}; }
    float tr = ar, ti = ai;
#pragma unroll
    for (int q = 0; q < 7; ++q) { const float nr2 = tr * tr - ti * ti, ni2 = 2.f * tr * ti; tr = nr2; ti = ni2; }
    d.aT = (f32x2){tr, ti};
}
template <bool WITH_Y>
DI void s5_group(const u32x2 w, const S5Dir& d, f32x2& st, float* U, unsigned* SB, int lane) {
    *(f32x4*)(U + (lane >> 2) * 16 + 4 * (lane & 3)) = (f32x4){bflo(w.x), bfhi(w.x), bflo(w.y), bfhi(w.y)};
    asm volatile("" ::: "memory"); __builtin_amdgcn_wave_barrier(); asm volatile("" ::: "memory");
    f32x4 n0 = *(const f32x4*)(U), n1 = *(const f32x4*)(U + 4), n2 = *(const f32x4*)(U + 8), n3 = *(const f32x4*)(U + 12);
#pragma unroll 4
    for (int k = 0; k < 16; ++k) {
        const f32x4 u0 = n0, u1 = n1, u2 = n2, u3 = n3;
        { const int kn = (k + 1) & 15;
          n0 = *(const f32x4*)(U + kn * 16); n1 = *(const f32x4*)(U + kn * 16 + 4); n2 = *(const f32x4*)(U + kn * 16 + 8); n3 = *(const f32x4*)(U + kn * 16 + 12); }
        f32x2 x0 = d.b[0] * u0[0], x1 = d.b[4] * u1[0], x2 = d.b[8] * u2[0], x3 = d.b[12] * u3[0];
#pragma unroll
        for (int j = 1; j < 4; ++j) { x0 += d.b[j] * u0[j]; x1 += d.b[4 + j] * u1[j]; x2 += d.b[8 + j] * u2[j]; x3 += d.b[12 + j] * u3[j]; }
        const f32x2 bu = (x0 + x1) + (x2 + x3);
        const f32x2 sw = (f32x2){-st.y, st.x};
        st = (st * d.a.x + bu) + sw * d.a.y;
        if (WITH_Y) SB[k * 68 + lane] = cvt_pk_bf16(st.x, st.y);
    }
    asm volatile("" ::: "memory"); __builtin_amdgcn_wave_barrier(); asm volatile("" ::: "memory");
}
DI u32x2 s5_ldu(const bf16_t* PROJ, int tokbase, int g, int dir, int grp, int lane) {
    const int o = grp * 16 + (lane >> 2); const int pos = dir ? (S5_TC - 1 - o) : o;
    return *(const u32x2*)(PROJ + (size_t)(tokbase + pos) * NPROJ + g * 16 + 4 * (lane & 3));
}
DI void s5_decode(int U, bool& lat, int& b, int& g, int& c, int& NC, int& tokbase, f32x2*& E, Frame& F) {
    if (U < 1024) { lat = false; b = U >> 5; g = (U >> 1) & 15; c = U & 1; NC = 2; tokbase = b * 256 + c * S5_TC; E = (f32x2*)(F.ws + OFF_ESTC) + (size_t)((b * 16 + g) * 2) * 2 * 64; }
    else { const int V = U - 1024; lat = true; b = V >> 9; g = (V >> 5) & 15; c = V & 31; NC = 32; tokbase = T_CTX + b * 4096 + c * S5_TC; E = (f32x2*)(F.ws + OFF_ESTL) + (size_t)((b * 16 + g) * 2) * 32 * 64; }
}
DI void s5_pass1(unsigned char* lds_, int wv_, int l) {
    Frame F = mkframe(lds_, wv_);
    const bf16_t* PROJ = (const bf16_t*)(F.ws + OFF_PROJ);
    const int lane = F.lane, n = lane & 15, kq = lane >> 4;
    const int xcd = F.bid & 7, slot = F.bid >> 3, nslot = (F.G + 7) >> 3;
    for (int t = slot; t < 80; t += nslot) {
        const int gd = 4 * xcd + t / 20, nt = t % 20, dir = gd & 1, g = gd >> 1;
        const bf16_t* A = (const bf16_t*)(F.ws + OFF_W128) + ((size_t)((l * 2 + dir) * 16 + g) * 128 + 16 * F.wave + n) * 2048 + 8 * kq;
        const int chunk = 16 * nt + n;
        const bf16_t* Bp = PROJ + (size_t)(chunk * 128 + (kq >> 1)) * NPROJ + g * 16 + 8 * (kq & 1);
        f32x4 acc = (f32x4){0.f, 0.f, 0.f, 0.f};
#pragma unroll 1
        for (int k0 = 0; k0 < 64; k0 += 16) {
            bf16x8 bf[16], af[16];
#pragma unroll
            for (int q = 0; q < 16; ++q) { bf[q] = *(const bf16x8*)(Bp + (size_t)(k0 + q) * (2 * NPROJ)); af[q] = *(const bf16x8*)(A + 32 * (k0 + q)); }
#pragma unroll
            for (int q = 0; q < 16; ++q) acc = __builtin_amdgcn_mfma_f32_16x16x32_bf16(af[q], bf[q], acc, 0, 0, 0);
        }
        f32x2* E; int NC, c;
        if (chunk < 64) { const int b = chunk >> 1; c = chunk & 1; NC = 2; E = (f32x2*)(F.ws + OFF_ESTC) + (size_t)((b * 16 + g) * 2) * 2 * 64; }
        else { const int v = chunk - 64, b = v >> 5; c = v & 31; NC = 32; E = (f32x2*)(F.ws + OFF_ESTL) + (size_t)((b * 16 + g) * 2) * 32 * 64; }
        const int j = dir ? (NC - 1 - c) : c;
        f32x2* Ej = E + (size_t)(dir * NC + j) * 64 + 8 * F.wave + 2 * kq;
        Ej[0] = (f32x2){acc[0], acc[1]}; Ej[1] = (f32x2){acc[2], acc[3]};
    }
}
typedef short s16x4 __attribute__((ext_vector_type(4)));
DI void s5_pass2(unsigned char* lds_, int wv_, int l) {
    Frame F = mkframe(lds_, wv_);
    const int gw = F.bid * NWAVES + F.wave, NGW = F.G * NWAVES;
    const bf16_t* PROJ = (const bf16_t*)(F.ws + OFF_PROJ); bf16_t* YS = (bf16_t*)(F.ws + OFF_YS);
    unsigned char* wl = F.lds + F.wave * S5_LDS_PER_WAVE;
    unsigned* SB = (unsigned*)(wl + 1024); float* YL = (float*)(wl + 5376);
    const int lane = F.lane, tk = lane & 15, rq = lane >> 4;
    unsigned* qctr = (unsigned*)(F.ws + OFF_CTL) + 3600 + 64 * l;
    (void)gw; (void)NGW;
    for (;;) {
        unsigned Uq = 0u; if (lane == 0) Uq = __hip_atomic_fetch_add(qctr, 1u, __ATOMIC_RELAXED, __HIP_MEMORY_SCOPE_AGENT);
        const int U = __builtin_amdgcn_readfirstlane((int)Uq);
        if (U >= 5120) break;
        bool lat; int b, g, c, NC, tokbase; f32x2* E; s5_decode(U, lat, b, g, c, NC, tokbase, E, F);
        for (int dir = 0; dir < 2; ++dir) {
            const int j = dir ? (NC - 1 - c) : c;
            f32x2 av, aT;
            { const int pi = ((l * 2 + dir) * 16 + g) * 64 + lane;
              const float lre = F.in[20][pi], lim = F.in[21][pi], dt = __expf(F.in[26][(l * 2 + dir) * 16 + g]);
              const float er = expf(lre * dt); float sn, cs; sincosf(lim * dt, &sn, &cs); av = (f32x2){er * cs, er * sn};
              float tr = av.x, ti = av.y;
#pragma unroll
              for (int q = 0; q < 7; ++q) { const float nr2 = tr * tr - ti * ti, ni2 = 2.f * tr * ti; tr = nr2; ti = ni2; }
              aT = (f32x2){tr, ti}; }
            bf16x8 cf[4];
            { const float* cre = F.in[24] + ((size_t)((l * 2 + dir) * 16 + g) * 16 + tk) * 64; const float* cim = F.in[25] + ((size_t)((l * 2 + dir) * 16 + g) * 16 + tk) * 64;
#pragma unroll
              for (int ks = 0; ks < 4; ++ks) { const f32x4 r = *(const f32x4*)(cre + 16 * ks + 4 * rq), m = *(const f32x4*)(cim + 16 * ks + 4 * rq);
                  u32x4 w; w.x = cvt_pk_bf16(r[0], -m[0]); w.y = cvt_pk_bf16(r[1], -m[1]); w.z = cvt_pk_bf16(r[2], -m[2]); w.w = cvt_pk_bf16(r[3], -m[3]);
                  cf[ks] = __builtin_bit_cast(bf16x8, w); } }
            s16x4 bA[8];
            { const bf16_t* wb = (const bf16_t*)(F.ws + OFF_W128) + ((size_t)((l * 2 + dir) * 16 + g) * 128 + tk) * 2048 + (dir ? 0 : 16 * 127) + 4 * rq;
#pragma unroll
              for (int mt = 0; mt < 8; ++mt) bA[mt] = __builtin_bit_cast(s16x4, *(const u32x2*)(wb + (size_t)mt * 16 * 2048)); }
            f32x2 st = (f32x2){0.f, 0.f};
            if (lat) st = *(const f32x2*)(F.in[4] + ((((size_t)b * 2 + l) * 2 + dir) * 16 + g) * 128 + lane * 2);
            auto ldu = [&](int grp) -> u32x2 { const int o = grp * 16 + tk; const int pos = dir ? (S5_TC - 1 - o) : o; return *(const u32x2*)(PROJ + (size_t)(tokbase + pos) * NPROJ + g * 16 + 4 * rq); };
            u32x2 wn = ldu(0);
            const f32x4 dv = *(const f32x4*)(F.in[27] + l * 256 + g * 16 + 4 * rq);
            for (int i0 = 0; i0 < j; i0 += 8) {
                f32x2 e[8];
#pragma unroll
                for (int q = 0; q < 8; ++q) e[q] = (i0 + q < j) ? E[(size_t)(dir * NC + i0 + q) * 64 + lane] : (f32x2){0.f, 0.f};
#pragma unroll
                for (int q = 0; q < 8; ++q) if (i0 + q < j) st = (f32x2){aT.x * st.x - aT.y * st.y + e[q].x, aT.x * st.y + aT.y * st.x + e[q].y};
            }
#pragma unroll 1
            for (int grp = 0; grp < S5_TC / 16; ++grp) {
                const u32x2 w = wn; if (grp + 1 < S5_TC / 16) wn = ldu(grp + 1);
                { const s16x4 ub = __builtin_bit_cast(s16x4, w);
#pragma unroll
                  for (int mt = 0; mt < 8; ++mt) { const f32x4 dd = __builtin_amdgcn_mfma_f32_16x16x16bf16_1k(bA[mt], ub, (f32x4){0.f, 0.f, 0.f, 0.f}, 0, 0, 0);
                      u32x2 pk; pk.x = cvt_pk_bf16_c(dd[0], dd[1]); pk.y = cvt_pk_bf16_c(dd[2], dd[3]); *(u32x2*)(SB + tk * 68 + 8 * mt + 2 * rq) = pk; } }
                asm volatile("" ::: "memory"); __builtin_amdgcn_wave_barrier(); asm volatile("" ::: "memory");
                { unsigned bw[16];
#pragma unroll
                  for (int k = 0; k < 16; ++k) bw[k] = SB[k * 68 + lane];
#pragma unroll
                  for (int k = 0; k < 16; ++k) { const f32x2 bu = (f32x2){bflo(bw[k]), bfhi(bw[k])}; const f32x2 sw = (f32x2){-st.y, st.x};
                      st = (st * av.x + bu) + sw * av.y; SB[k * 68 + lane] = cvt_pk_bf16(st.x, st.y); } }
                asm volatile("" ::: "memory"); __builtin_amdgcn_wave_barrier(); asm volatile("" ::: "memory");
                f32x4 y = (f32x4){0.f, 0.f, 0.f, 0.f};
#pragma unroll
                for (int ks = 0; ks < 4; ++ks) { const bf16x8 sf = *(const bf16x8*)(SB + tk * 68 + ks * 16 + 4 * rq); y = __builtin_amdgcn_mfma_f32_16x16x32_bf16(cf[ks], sf, y, 0, 0, 0); }
                const int o = grp * 16 + tk; const int pos = dir ? (S5_TC - 1 - o) : o;
                if (dir == 0) { *(f32x4*)(YL + pos * 16 + 4 * rq) = y; }
                else {
                    const f32x4 yf = *(const f32x4*)(YL + pos * 16 + 4 * rq);
                    const float y0 = gelu_tanh(y[0] + yf[0] + dv[0] * bflo(w.x)), y1 = gelu_tanh(y[1] + yf[1] + dv[1] * bfhi(w.x));
                    const float y2 = gelu_tanh(y[2] + yf[2] + dv[2] * bflo(w.y)), y3 = gelu_tanh(y[3] + yf[3] + dv[3] * bfhi(w.y));
                    u32x2 ov; ov.x = cvt_pk_bf16(y0, y1); ov.y = cvt_pk_bf16(y2, y3);
                    *(u32x2*)(YS + (size_t)(tokbase + pos) * 256 + g * 16 + 4 * rq) = ov;
                }
                asm volatile("" ::: "memory"); __builtin_amdgcn_wave_barrier(); asm volatile("" ::: "memory");
            }
            if (!lat && j == NC - 1) *(f32x2*)(F.out + OUT_SSM + ((((size_t)b * 2 + l) * 2 + dir) * 16 + g) * 128 + lane * 2) = st;
        }
    }
}

constexpr int AT_ROWB = 144, AT_TILEB = 64 * AT_ROWB, AT_BUFB = 2 * AT_TILEB;
DI int crow(int r, int hi) { return (r & 3) + 8 * (r >> 2) + 4 * hi; }
DI void attn_unit(Frame& F, int l, int g, bool lat, int b, int hk, int qb) {
    const bf16_t* PROJ = (const bf16_t*)(F.ws + OFF_PROJ); const bf16_t* KR = (const bf16_t*)(F.ws + OFF_KR);
    bf16_t* MERGED = (bf16_t*)(F.ws + OFF_MERGED);
    const int lane = F.lane, w = F.wave, r32 = lane & 31, hi = lane >> 5, tid = F.tid;
    const int hq = hk * 2 + (w >> 2), qrow = 32 * (w & 3) + r32, q0 = qb * 128;
    const int seq0 = lat ? T_CTX + b * 4096 : b * 256;
    const int tok = seq0 + q0 + qrow, qpos = q0 + qrow;
    bf16x8 qr[4];
    {
        bf16x8 qn[4];
        const bf16_t* qp = PROJ + (size_t)tok * NPROJ + (g ? 768 : 256) + hq * 64;
        float q[4][8]; float ss = 0.f;
#pragma unroll
        for (int s = 0; s < 4; ++s) { const u32x4 v = *(const u32x4*)(qp + 16 * s + 8 * hi);
            q[s][0] = bflo(v.x); q[s][1] = bfhi(v.x); q[s][2] = bflo(v.y); q[s][3] = bfhi(v.y); q[s][4] = bflo(v.z); q[s][5] = bfhi(v.z); q[s][6] = bflo(v.w); q[s][7] = bfhi(v.w);
#pragma unroll
            for (int j = 0; j < 8; ++j) ss += q[s][j] * q[s][j]; }
        if (g) { ss += shx(ss, 32, lane); const float rn = rsqrtf(ss * (1.f / 64.f) + EPSF);
#pragma unroll
            for (int s = 0; s < 4; ++s) { const f32x4 g0 = *(const f32x4*)(F.in[31] + l * 64 + 16 * s + 8 * hi), g1 = *(const f32x4*)(F.in[31] + l * 64 + 16 * s + 8 * hi + 4);
#pragma unroll
                for (int j = 0; j < 4; ++j) { q[s][j] *= rn * g0[j]; q[s][4 + j] *= rn * g1[j]; } } }
#pragma unroll
        for (int s = 0; s < 4; ++s) { u32x4 wv; wv.x = cvt_pk_bf16(q[s][0] * C2, q[s][1] * C2); wv.y = cvt_pk_bf16(q[s][2] * C2, q[s][3] * C2); wv.z = cvt_pk_bf16(q[s][4] * C2, q[s][5] * C2); wv.w = cvt_pk_bf16(q[s][6] * C2, q[s][7] * C2);
            qn[s] = __builtin_bit_cast(bf16x8, wv); }
        if (lat) {
            const f32x2* rp = (const f32x2*)(F.ws + OFF_ROPE) + (size_t)qpos * 32;
#pragma unroll
            for (int s = 0; s < 2; ++s) { float o1[8], o2[8];
#pragma unroll
                for (int j = 0; j < 8; ++j) { const f32x2 cs = rp[16 * s + 8 * hi + j]; const float x1 = q[s][j], x2 = q[s + 2][j]; o1[j] = (x1 * cs.x - x2 * cs.y) * C2; o2[j] = (x2 * cs.x + x1 * cs.y) * C2; }
                u32x4 w1, w2; w1.x = cvt_pk_bf16(o1[0], o1[1]); w1.y = cvt_pk_bf16(o1[2], o1[3]); w1.z = cvt_pk_bf16(o1[4], o1[5]); w1.w = cvt_pk_bf16(o1[6], o1[7]);
                w2.x = cvt_pk_bf16(o2[0], o2[1]); w2.y = cvt_pk_bf16(o2[2], o2[3]); w2.z = cvt_pk_bf16(o2[4], o2[5]); w2.w = cvt_pk_bf16(o2[6], o2[7]);
                qr[s] = __builtin_bit_cast(bf16x8, w1); qr[s + 2] = __builtin_bit_cast(bf16x8, w2); }
        } else {
#pragma unroll
            for (int s = 0; s < 4; ++s) qr[s] = qn[s];
        }
#pragma unroll
        for (int s = 0; s < 4; ++s) *(bf16x8*)(F.lds + 40960 + w * 4096 + s * 1024 + lane * 16) = qn[s];
    }
    int kstart = 0, nt0, nt1;
    if (!lat) { nt0 = 4; nt1 = 0; }
    else if (g == 0) { kstart = q0 - 128 < 0 ? 0 : q0 - 128; const int ke = q0 + 256 > 4096 ? 4096 : q0 + 256; nt0 = (ke - kstart) >> 6; nt1 = 4; }
    else { nt0 = 64; nt1 = 4; }
    const int NT = nt0 + nt1;
    const bf16_t* K0 = KR + (size_t)(seq0 + kstart) * 256 + g * 128 + hk * 64;
    const bf16_t* V0 = PROJ + (size_t)(seq0 + kstart) * NPROJ + (g ? 1152 : 640) + hk * 64;
    const bf16_t* K1 = (const bf16_t*)(F.ws + OFF_CKV) + ((((size_t)(l * 2 + g) * 8 + b) * 2 + 0) * 256) * 128 + hk * 64;
    const bf16_t* V1 = K1 + 256 * 128;
    const int lkey = tid >> 3, lch = tid & 7;
    const unsigned ko0 = (unsigned)lkey * 512u + (unsigned)lch * 16u, vo0 = (unsigned)lkey * (NPROJ * 2u) + (unsigned)lch * 16u, o1_ = (unsigned)lkey * 256u + (unsigned)lch * 16u;
    auto ldk = [&](int ti) -> u32x4 { const bool a = ti < nt0; const char* base = a ? (const char*)K0 + (size_t)ti * (64 * 512) : (const char*)K1 + (size_t)(ti - nt0) * (64 * 256); const unsigned off = a ? ko0 : o1_; return *(const u32x4*)(base + off); };
    auto ldv = [&](int ti) -> u32x4 { const bool a = ti < nt0; const char* base = a ? (const char*)V0 + (size_t)ti * (64 * NPROJ * 2) : (const char*)V1 + (size_t)(ti - nt0) * (64 * 256); const unsigned off = a ? vo0 : o1_; return *(const u32x4*)(base + off); };
    auto stage = [&](int buf, const u32x4& kv, const u32x4& vv) {
        unsigned char* kb = F.lds + buf * AT_BUFB; unsigned char* vb = kb + AT_TILEB;
        *(u32x4*)(kb + lkey * AT_ROWB + lch * 16) = kv;
        bf16_t* vt = (bf16_t*)vb + (lkey ^ (lch << 3));
        const int d0 = lch * 8;
        vt[(d0 + 0) * 72] = (bf16_t)(vv.x & 0xffff); vt[(d0 + 1) * 72] = (bf16_t)(vv.x >> 16); vt[(d0 + 2) * 72] = (bf16_t)(vv.y & 0xffff); vt[(d0 + 3) * 72] = (bf16_t)(vv.y >> 16);
        vt[(d0 + 4) * 72] = (bf16_t)(vv.z & 0xffff); vt[(d0 + 5) * 72] = (bf16_t)(vv.z >> 16); vt[(d0 + 6) * 72] = (bf16_t)(vv.w & 0xffff); vt[(d0 + 7) * 72] = (bf16_t)(vv.w >> 16);
    };
    float mrun, lrun;
    if (g == 0) { mrun = F.in[30][l * 4 + hq] * LOG2E; lrun = hi ? 0.f : 1.f; } else { mrun = -1e30f; lrun = 0.f; }
    f32x16 o0, o1;
#pragma unroll
    for (int r = 0; r < 16; ++r) { o0[r] = 0.f; o1[r] = 0.f; }
    __syncthreads();
    u32x4 kreg = ldk(0), vreg = ldv(0);
    stage(0, kreg, vreg);
    if (NT > 1) { kreg = ldk(1); vreg = ldv(1); }
    __syncthreads();
    const bool band = lat && g == 0;
    for (int ti = 0; ti < NT; ++ti) {
        const unsigned char* kb = F.lds + (ti & 1) * AT_BUFB; const unsigned char* vb = kb + AT_TILEB;
        const bool s1 = ti >= nt0;
        if (ti == nt0) {
#pragma unroll
            for (int s = 0; s < 4; ++s) qr[s] = *(const bf16x8*)(F.lds + 40960 + w * 4096 + s * 1024 + lane * 16);
        }
        f32x16 p0, p1;
#pragma unroll
        for (int r = 0; r < 16; ++r) { p0[r] = 0.f; p1[r] = 0.f; }
#pragma unroll
        for (int s = 0; s < 4; ++s) {
            const bf16x8 ka = *(const bf16x8*)(kb + r32 * AT_ROWB + (16 * s + 8 * hi) * 2);
            const bf16x8 kc = *(const bf16x8*)(kb + (32 + r32) * AT_ROWB + (16 * s + 8 * hi) * 2);
            const bf16x8 qf = qr[s];
            p0 = __builtin_amdgcn_mfma_f32_32x32x16_bf16(ka, qf, p0, 0, 0, 0);
            p1 = __builtin_amdgcn_mfma_f32_32x32x16_bf16(kc, qf, p1, 0, 0, 0);
        }
        if (band && !s1) {
            const int kp0 = kstart + ti * 64;
#pragma unroll
            for (int r = 0; r < 16; ++r) { const int kp = kp0 + crow(r, hi); int dlt = qpos - kp; dlt = dlt < 0 ? -dlt : dlt; if (dlt > 128) p0[r] = -1e30f; int d2 = qpos - kp - 32; d2 = d2 < 0 ? -d2 : d2; if (d2 > 128) p1[r] = -1e30f; }
        }
        float rm = fmaxf(p0[0], p1[0]);
#pragma unroll
        for (int r = 1; r < 16; ++r) rm = fmaxf(rm, fmaxf(p0[r], p1[r]));
        rm = fmaxf(rm, shx(rm, 32, lane));
        const float mnew = fmaxf(mrun, rm), alpha = __builtin_amdgcn_exp2f(mrun - mnew); mrun = mnew;
        float rs = 0.f;
#pragma unroll
        for (int r = 0; r < 16; ++r) { p0[r] = __builtin_amdgcn_exp2f(p0[r] - mnew); p1[r] = __builtin_amdgcn_exp2f(p1[r] - mnew); rs += p0[r] + p1[r]; }
        lrun = lrun * alpha + rs;
        if (__builtin_amdgcn_ballot_w64(alpha != 1.0f) != 0ull) {
#pragma unroll
            for (int r = 0; r < 16; ++r) { o0[r] *= alpha; o1[r] *= alpha; }
        }
        bf16x8 pf[4];
        { u32x4 a; a.x = cvt_pk_bf16(p0[0], p0[1]); a.y = cvt_pk_bf16(p0[2], p0[3]); a.z = cvt_pk_bf16(p0[4], p0[5]); a.w = cvt_pk_bf16(p0[6], p0[7]); pf[0] = __builtin_bit_cast(bf16x8, a);
          a.x = cvt_pk_bf16(p0[8], p0[9]); a.y = cvt_pk_bf16(p0[10], p0[11]); a.z = cvt_pk_bf16(p0[12], p0[13]); a.w = cvt_pk_bf16(p0[14], p0[15]); pf[1] = __builtin_bit_cast(bf16x8, a);
          a.x = cvt_pk_bf16(p1[0], p1[1]); a.y = cvt_pk_bf16(p1[2], p1[3]); a.z = cvt_pk_bf16(p1[4], p1[5]); a.w = cvt_pk_bf16(p1[6], p1[7]); pf[2] = __builtin_bit_cast(bf16x8, a);
          a.x = cvt_pk_bf16(p1[8], p1[9]); a.y = cvt_pk_bf16(p1[10], p1[11]); a.z = cvt_pk_bf16(p1[12], p1[13]); a.w = cvt_pk_bf16(p1[14], p1[15]); pf[3] = __builtin_bit_cast(bf16x8, a); }
#pragma unroll
        for (int ks = 0; ks < 4; ++ks) {
            const int ka = (16 * ks + 4 * hi) ^ ((r32 >> 3) << 3), kc = ka ^ 32;
            const unsigned char* vp = vb + r32 * AT_ROWB;
            const u32x2 a0 = *(const u32x2*)(vp + ka * 2), a1 = *(const u32x2*)(vp + (ka ^ 8) * 2);
            const u32x2 c0 = *(const u32x2*)(vp + 32 * AT_ROWB + kc * 2), c1 = *(const u32x2*)(vp + 32 * AT_ROWB + (kc ^ 8) * 2);
            const u32x4 fa = (u32x4){a0.x, a0.y, a1.x, a1.y}, fc = (u32x4){c0.x, c0.y, c1.x, c1.y};
            o0 = __builtin_amdgcn_mfma_f32_32x32x16_bf16(__builtin_bit_cast(bf16x8, fa), pf[ks], o0, 0, 0, 0);
            o1 = __builtin_amdgcn_mfma_f32_32x32x16_bf16(__builtin_bit_cast(bf16x8, fc), pf[ks], o1, 0, 0, 0);
        }
        if (ti + 1 < NT) { stage((ti + 1) & 1, kreg, vreg); if (ti + 2 < NT) { kreg = ldk(ti + 2); vreg = ldv(ti + 2); } }
        __syncthreads();
    }
    lrun += shx(lrun, 32, lane);
    const float inv = 1.f / lrun;
    bf16_t* op = MERGED + (size_t)tok * DM + (g ? 512 : 256) + hq * 64 + 4 * hi;
#pragma unroll
    for (int i = 0; i < 4; ++i) {
        u32x2 a; a.x = cvt_pk_bf16(o0[4 * i] * inv, o0[4 * i + 1] * inv); a.y = cvt_pk_bf16(o0[4 * i + 2] * inv, o0[4 * i + 3] * inv);
        u32x2 c; c.x = cvt_pk_bf16(o1[4 * i] * inv, o1[4 * i + 1] * inv); c.y = cvt_pk_bf16(o1[4 * i + 2] * inv, o1[4 * i + 3] * inv);
        *(u32x2*)(op + 8 * i) = a; *(u32x2*)(op + 32 + 8 * i) = c;
    }
}
DI void attn_phase(unsigned char* lds_, int wv_, int l) {
    Frame F = mkframe(lds_, wv_);
    for (int u = F.bid; u < 512; u += F.G) attn_unit(F, l, 1, true, u >> 6, (u >> 5) & 1, u & 31);
    for (int u = F.bid; u < 512; u += F.G) attn_unit(F, l, 0, true, u >> 6, (u >> 5) & 1, u & 31);
    for (int u = F.bid; u < 256; u += F.G) attn_unit(F, l, u >> 7, false, (u >> 2) & 31, (u >> 1) & 1, u & 1);
    __syncthreads();
}

DI void ph_gateup(unsigned char* lds_, int wv_, int l, int f) { Frame F = mkframe(lds_, wv_);
    pg8::SchedStd S; S.init((const unsigned char*)F.out, F.ws + OFF_WGU + (size_t)(l * 2 + f) * SZ_WGU, DM * 2, DM * 2, T_ALL, 2 * FF, F.G, F.bid);
    pg8::EpiSwiglu E{(bf16_t*)(F.ws + OFF_HID)}; pg8::gemm_phase<true>(F.ldsl, fresh(F.tid), pg8::Cfg{DM * 2, DM * 2, DM}, S, E); }
template <bool IN32, bool OUT32>
DI void down_gemms(Frame& F, const void* h0, const void* h1, void* ho, const float* gate, const unsigned char* W) {
    { pg8::SchedStd S; S.init(F.ws + OFF_HID, W, FF * 2, FF * 2, 128 * 256, DM, F.G, F.bid);
      pg8::EpiResid<IN32, OUT32> E{h0, h1, ho, gate, 0.5f}; pg8::gemm_phase<false>(F.ldsl, fresh(F.tid), pg8::Cfg{FF * 2, FF * 2, FF}, S, E); }
    { pg8::SchedHN S{(const char*)(F.ws + OFF_HID), (const char*)W, FF * 2, FF * 2, F.G, F.bid};
      pg8::EpiResidHN<IN32, OUT32> E{h0, h1, ho, gate, 0.5f}; pg8::gemm_phase_hn<false>(F.ldsl, fresh(F.tid), pg8::Cfg{FF * 2, FF * 2, FF}, S, E); }
}
DI void ph_down(unsigned char* lds_, int wv_, int l, int f, bool first) { Frame F = mkframe(lds_, wv_);
    bf16_t* HB = (bf16_t*)(F.ws + OFF_HB);
    const float* gate = (const float*)(F.ws + OFF_MOD) + (size_t)l * 9 * 9216 + (f ? 8 : 2) * 1024;
    const unsigned char* W = F.ws + OFF_WDN + (size_t)(l * 2 + f) * SZ_WDN;
    if (first) down_gemms<true, false>(F, F.in[0], F.in[1], HB, gate, W);
    else if (l == 1 && f == 1) down_gemms<false, true>(F, HB, HB + (size_t)T_CTX * DM, F.out, gate, W);
    else down_gemms<false, false>(F, HB, HB + (size_t)T_CTX * DM, HB, gate, W);
}
DI void ph_win(unsigned char* lds_, int wv_, int l) { Frame F = mkframe(lds_, wv_);
    const unsigned char* XN = (const unsigned char*)F.out; const unsigned char* WIN = F.ws + OFF_WIN + (size_t)l * NPROJ * DM * 2; const unsigned char* WINF = F.ws + OFF_WINF + (size_t)l * 512 * DM * 2;
    { pg8::SchedStd S; S.init(XN, WIN, DM * 2, DM * 2, 153 * 256, NPROJ, F.G, F.bid);
      pg8::EpiStore E{(bf16_t*)(F.ws + OFF_PROJ), NPROJ}; pg8::gemm_phase<true>(F.ldsl, fresh(F.tid), pg8::Cfg{DM * 2, DM * 2, DM}, S, E); }
    { pg8::SchedStd S; S.init(WINF, XN, DM * 2, DM * 2, 512, 128 * 256, F.G, F.bid);
      pg8::EpiStore E{(bf16_t*)(F.ws + OFF_PQT), T_ALL}; pg8::gemm_phase<true>(F.ldsl, fresh(F.tid), pg8::Cfg{DM * 2, DM * 2, DM}, S, E); }
    { pg8::SchedWinTail S{(const char*)XN, (const char*)WIN, (const char*)WINF, F.G, F.bid};
      pg8::EpiStoreHN E{(bf16_t*)(F.ws + OFF_PROJ), NPROJ, (ptrdiff_t)OFF_PQT - (ptrdiff_t)OFF_PROJ, T_ALL}; pg8::gemm_phase_hn<true>(F.ldsl, fresh(F.tid), pg8::Cfg{DM * 2, DM * 2, DM}, S, E); } }
DI void dft_row0(unsigned char* lds_, int wv_) { Frame F = mkframe(lds_, wv_);
    const int gw = F.bid * NWAVES + F.wave, NGW = F.G * NWAVES;
    const bf16_t* PQT = (const bf16_t*)(F.ws + OFF_PQT); bf16_t* FCS = (bf16_t*)(F.out);
    for (int t = gw; t < 8 * 256; t += NGW) { const int b = t >> 8, ch = t & 255; const int seq0 = T_CTX + b * 4096;
        const bf16_t* p = PQT + (size_t)ch * T_ALL + seq0 + F.lane * 8; float a = 0.f;
#pragma unroll
        for (int q = 0; q < 8; ++q) { const u32x4 v = *(const u32x4*)(p + q * 512); a += (bflo(v.x) + bfhi(v.x)) + (bflo(v.y) + bfhi(v.y)) + (bflo(v.z) + bfhi(v.z)) + (bflo(v.w) + bfhi(v.w)); }
        a = wave_sum(a, F.lane);
        if (F.lane == 0) FCS[(size_t)seq0 * 1024 + ch] = (bf16_t)f2bf(a * (1.f / 64.f));
        if (ch == 0) { bf16_t* z = FCS + (size_t)seq0 * 1024 + 256 + F.lane * 12;
            *(u32x2*)z = (u32x2){0u, 0u}; *(u32x2*)(z + 4) = (u32x2){0u, 0u}; *(u32x2*)(z + 8) = (u32x2){0u, 0u}; } }
}
DI void ph_dft(unsigned char* lds_, int wv_) { Frame F = mkframe(lds_, wv_);
    { pg8::SchedDftLat S{(const char*)(F.ws + OFF_TC4), OFF_TS4 - OFF_TC4, (const char*)(F.ws + OFF_PQT), F.G, F.bid};
      pg8::EpiDftSym E{(bf16_t*)(F.out)}; pg8::gemm_phase<true>(F.ldsl, fresh(F.tid), pg8::Cfg{8192, T_ALL * 2, 2048}, S, E); }
    { pg8::SchedDftCtx S{(const char*)(F.ws + OFF_TC2), OFF_TS2 - OFF_TC2, (const char*)(F.ws + OFF_PQT), F.G, F.bid};
      pg8::EpiDftCtx E{(bf16_t*)(F.out)}; pg8::gemm_phase<true>(F.ldsl, fresh(F.tid), pg8::Cfg{512, T_ALL * 2, 256}, S, E); } }
DI void ph_post(unsigned char* lds_, int wv_, int l) { Frame F = mkframe(lds_, wv_);
    { pg8::SchedStd S; S.init(F.ws + OFF_YS, F.ws + OFF_WGLU + (size_t)l * 65536 * 2, 512, 512, T_ALL, 256, F.G, F.bid);
      pg8::EpiGlu E{(const bf16_t*)(F.ws + OFF_YS), F.in[29] + l * 256, (bf16_t*)(F.ws + OFF_MERGED)}; pg8::gemm_phase<true>(F.ldsl, fresh(F.tid), pg8::Cfg{512, 512, 256}, S, E); }
    { pg8::SchedStd S; S.init((const unsigned char*)F.out, F.ws + OFF_WFN + (size_t)l * 256 * 1024 * 2, 2048, 2048, T_ALL, 256, F.G, F.bid);
      pg8::EpiBias E{F.in[34] + l * 256, (bf16_t*)(F.ws + OFF_MERGED), 768}; pg8::gemm_phase<true>(F.ldsl, fresh(F.tid), pg8::Cfg{2048, 2048, 1024}, S, E); } }
DI void ph_wout(unsigned char* lds_, int wv_, int l) { Frame F = mkframe(lds_, wv_);
    bf16_t* HB = (bf16_t*)(F.ws + OFF_HB); const float* gate = (const float*)(F.ws + OFF_MOD) + (size_t)l * 9 * 9216 + 5 * 1024;
    const unsigned char* W = F.ws + OFF_WOUT + (size_t)l * DM * DM * 2;
    { pg8::SchedStd S; S.init(F.ws + OFF_MERGED, W, DM * 2, DM * 2, 128 * 256, DM, F.G, F.bid);
      pg8::EpiResid<false, false> E{HB, HB + (size_t)T_CTX * DM, HB, gate, 1.0f}; pg8::gemm_phase<false>(F.ldsl, fresh(F.tid), pg8::Cfg{DM * 2, DM * 2, DM}, S, E); }
    { pg8::SchedHN S{(const char*)(F.ws + OFF_MERGED), (const char*)W, DM * 2, DM * 2, F.G, F.bid};
      pg8::EpiResidHN<false, false> E{HB, HB + (size_t)T_CTX * DM, HB, gate, 1.0f}; pg8::gemm_phase_hn<false>(F.ldsl, fresh(F.tid), pg8::Cfg{DM * 2, DM * 2, DM}, S, E); } }

__global__ void __launch_bounds__(NTHREADS, 2) mega_fwd(Params P) {
    extern __shared__ __attribute__((aligned(16))) unsigned char lds[];
    cg::grid_group grid = cg::this_grid();
#define GSYNC() do { asm volatile("s_waitcnt vmcnt(0) lgkmcnt(0)" ::: "memory"); grid.sync(); __builtin_amdgcn_fence(__ATOMIC_ACQUIRE, "agent"); asm volatile("s_waitcnt vmcnt(0)" ::: "memory"); } while (0)
    const int wv0 = __builtin_amdgcn_readfirstlane((int)(threadIdx.x >> 6));
    if (threadIdx.x == 0) {
#pragma unroll
        for (int i = 0; i < 36; ++i) *(unsigned long long*)(lds + PTAB_OFF + 8 * i) = (unsigned long long)P.in[i];
        *(unsigned long long*)(lds + PTAB_OFF + 8 * 36) = (unsigned long long)P.out; *(unsigned long long*)(lds + PTAB_OFF + 8 * 37) = (unsigned long long)P.ws;
        *(unsigned*)(lds + XBST_OFF) = 0u; *(unsigned*)(lds + XBST_OFF + 4) = 0u;
        (void)xb_add((unsigned*)(P.ws + OFF_CTL) + XB_XCNT(xb_xcc_id()), 1u); }
    __syncthreads();
#undef GSYNC
#define GSYNC() xcd_sync(lds, wv0)
    if (gridDim.x == 0x7fffffffu) grid.sync();
    p0_phase(lds, wv0);
    GSYNC();
#define FFN_PHASES(l, f, first) do { norm_phase(lds, wv0, l, (f) ? 2 : 0, first); GSYNC(); ph_gateup(lds, wv0, l, f); GSYNC(); ph_down(lds, wv0, l, f, first); GSYNC(); } while (0)
#define MIX_PHASES(l) do { norm_phase(lds, wv0, l, 1, false); GSYNC(); ph_win(lds, wv0, l); GSYNC(); kprep_phase(lds, wv0, l); s5_pass1(lds, wv0, l); GSYNC(); \
        attn_phase(lds, wv0, l); dft_row0(lds, wv0); ph_dft(lds, wv0); __syncthreads(); s5_pass2(lds, wv0, l); GSYNC(); ph_post(lds, wv0, l); GSYNC(); ph_wout(lds, wv0, l); GSYNC(); } while (0)
    FFN_PHASES(0, 0, true); MIX_PHASES(0); FFN_PHASES(0, 1, false);
    FFN_PHASES(1, 0, false); MIX_PHASES(1); FFN_PHASES(1, 1, false);
    final_norm_phase(lds, wv0);
}

extern "C" void kernel_launch(void* const* d_in, const int* in_sizes, int n_in, void* d_out, int out_size, void* d_ws, size_t ws_size, hipStream_t stream) {
    static int grid = 0;
    if (grid == 0) {
        int dev = 0, cus = 0, per_cu = 0;
        hipGetDevice(&dev);
        hipDeviceGetAttribute(&cus, hipDeviceAttributeMultiprocessorCount, dev);
        if (hipFuncSetAttribute((const void*)mega_fwd, hipFuncAttributeMaxDynamicSharedMemorySize, LDS_BYTES) != hipSuccess) { fprintf(stderr, "hipFuncSetAttribute failed\n"); }
        if (hipOccupancyMaxActiveBlocksPerMultiprocessor(&per_cu, (const void*)mega_fwd, NTHREADS, LDS_BYTES) != hipSuccess || per_cu < 1) { fprintf(stderr, "occupancy query: %d\n", per_cu); per_cu = 1; }
        (void)hipGetLastError();
        grid = cus * 1;
        if (n_in != 36 || ws_size < WS_TOTAL) { fprintf(stderr, "kernel_launch: unexpected n_in %d / ws %zu (need %zu)\n", n_in, ws_size, (size_t)WS_TOTAL); grid = -1; }
    }
    if (grid < 0) return;
    if (hipMemsetAsync((char*)d_ws + OFF_CTL, 0, CTL_BYTES, stream) != hipSuccess) { fprintf(stderr, "memset failed\n"); return; }
    Params p{};
    for (int i = 0; i < 36; ++i) p.in[i] = (const float*)d_in[i];
    p.out = (float*)d_out; p.ws = (unsigned char*)d_ws;
    void* args[] = {&p};
    hipError_t e = hipLaunchCooperativeKernel((const void*)mega_fwd, dim3(grid), dim3(NTHREADS), args, LDS_BYTES, stream);
    if (e != hipSuccess) fprintf(stderr, "cooperative launch failed: %s (grid %d)\n", hipGetErrorString(e), grid);
}
```

```cpp
#include <hip/hip_runtime.h>
#include <hip/hip_cooperative_groups.h>
#include <cstdio>
#include <cstdint>
namespace cg = cooperative_groups;

#define DI __device__ __forceinline__
#define LAS __attribute__((address_space(3)))
typedef unsigned short bf16_t;
typedef short bf16x8 __attribute__((ext_vector_type(8)));
typedef float f32x4 __attribute__((ext_vector_type(4)));
typedef float f32x2 __attribute__((ext_vector_type(2)));
typedef float f32x16 __attribute__((ext_vector_type(16)));
typedef unsigned u32x4 __attribute__((ext_vector_type(4)));
typedef unsigned u32x2 __attribute__((ext_vector_type(2)));

constexpr int DM = 1024, FF = 2816, T_CTX = 8192, T_LAT = 32768, T_ALL = 40960, NPROJ = 1280, NMOD = 9;
constexpr int NTHREADS = 512, NWAVES = 8;
constexpr float EPSF = 1e-6f;
constexpr float C2 = 0.125f * 1.4426950408889634f;
constexpr float LOG2E = 1.4426950408889634f;

constexpr size_t SZ_WGU = (size_t)2 * FF * DM * 2, SZ_WDN = (size_t)DM * FF * 2;
constexpr size_t OFF_WGU = 0;
constexpr size_t OFF_WDN = OFF_WGU + 4 * SZ_WGU;
constexpr size_t OFF_WIN = OFF_WDN + 4 * SZ_WDN;
constexpr size_t OFF_WINF = OFF_WIN + 2 * (size_t)NPROJ * DM * 2;
constexpr size_t OFF_WOUT = OFF_WINF + 2 * (size_t)512 * DM * 2;
constexpr size_t OFF_WGLU = OFF_WOUT + 2 * (size_t)DM * DM * 2;
constexpr size_t OFF_WFN = OFF_WGLU + 2 * (size_t)256 * 256 * 2;
constexpr size_t OFF_TC4 = OFF_WFN + 2 * (size_t)256 * 1024 * 2;
constexpr size_t OFF_TS4 = OFF_TC4 + (size_t)2056 * 4096 * 2;
constexpr size_t OFF_TC2 = OFF_TS4 + (size_t)2056 * 4096 * 2;
constexpr size_t OFF_TS2 = OFF_TC2 + (size_t)256 * 256 * 2;
constexpr size_t OFF_MOD = OFF_TS2 + (size_t)256 * 256 * 2;
constexpr size_t OFF_ROPE = OFF_MOD + (size_t)2 * 9 * 9216 * 4;
constexpr size_t OFF_CKV = OFF_ROPE + (size_t)4096 * 32 * 8;
constexpr size_t OFF_ESTC = OFF_CKV + (size_t)2 * 2 * 8 * 2 * 256 * 128 * 2;
constexpr size_t OFF_ESTL = OFF_ESTC + (size_t)32 * 16 * 2 * 2 * 64 * 8;
constexpr size_t OFF_XN = OFF_ESTL + (size_t)8 * 16 * 2 * 32 * 64 * 8;
constexpr size_t OFF_HB = OFF_XN;
constexpr size_t OFF_FCS = OFF_XN;
constexpr size_t OFF_HID = OFF_XN + (size_t)T_ALL * DM * 2;
constexpr size_t OFF_PROJ = OFF_HID;
constexpr size_t OFF_MERGED = OFF_PROJ + (size_t)T_ALL * NPROJ * 2;
constexpr size_t OFF_PQT = OFF_MERGED + (size_t)T_ALL * DM * 2;
constexpr size_t WS_END = OFF_HID + (size_t)T_ALL * FF * 2;
constexpr size_t OFF_CTL = WS_END, CTL_BYTES = 16384;
constexpr size_t OFF_W128 = WS_END + CTL_BYTES;
constexpr size_t OFF_YS = OFF_W128 + (size_t)2 * 2 * 16 * 128 * 2048 * 2;
constexpr size_t OFF_KR = OFF_YS + (size_t)T_ALL * 256 * 2;
constexpr size_t WS_TOTAL = OFF_KR + (size_t)T_ALL * 256 * 2;
static_assert(OFF_PQT + (size_t)512 * T_ALL * 2 <= WS_END, "overlay");
static_assert(WS_TOTAL <= (size_t)536870912, "ws budget");
static_assert(OFF_XN % 256 == 0 && OFF_HID % 256 == 0 && OFF_TC4 % 256 == 0, "align");

constexpr size_t OUT_SWA = (size_t)T_ALL * DM;
constexpr size_t OUT_AX = OUT_SWA + (size_t)32 * 2 * 2 * 256 * 128;
constexpr size_t OUT_SSM = OUT_AX + (size_t)32 * 2 * 2 * 256 * 128;

constexpr int LDS_BYTES = 131072 + 1024;

struct Params { const float* in[36]; float* out; unsigned char* ws; };

DI unsigned cvt_pk_bf16(float lo, float hi) { unsigned r; asm volatile("v_cvt_pk_bf16_f32 %0, %1, %2" : "=v"(r) : "v"(lo), "v"(hi)); return r; }
typedef __bf16 bf16x2_t __attribute__((ext_vector_type(2)));
DI unsigned cvt_pk_bf16_c(float lo, float hi) { const f32x2 v = {lo, hi}; const bf16x2_t b = __builtin_convertvector(v, bf16x2_t); return __builtin_bit_cast(unsigned, b); }
DI unsigned f2bf(float f) { unsigned u = __float_as_uint(f); return (u + 0x7fffu + ((u >> 16) & 1u)) >> 16; }
DI float bflo(unsigned w) { return __uint_as_float(w << 16); }
DI float bfhi(unsigned w) { return __uint_as_float(w & 0xffff0000u); }
DI float bf1(bf16_t v) { return __uint_as_float(((unsigned)v) << 16); }
DI float shx(float v, int o, int lane) { return __int_as_float(__builtin_amdgcn_ds_bpermute((lane ^ o) << 2, __float_as_int(v))); }
DI float wave_sum(float v, int lane) {
#pragma unroll
    for (int o = 1; o < 64; o <<= 1) v += shx(v, o, lane);
    return v;
}
DI int fresh(int v) { asm volatile("" : "+v"(v)); return v; }
DI float silu_f(float x) { return x / (1.f + __expf(-x)); }
DI float sigmoid_f(float x) { return 1.f / (1.f + __expf(-x)); }
DI float gelu_tanh(float x) { const float z = 0.7978845608028654f * (x + 0.044715f * x * x * x); const float e = __expf(2.f * z); return 0.5f * x * (2.f - 2.f / (e + 1.f)); }

namespace pg8 {
constexpr int BM = 256, BK = 64, HALF = 128, HTB = HALF * BK * 2, NXCD = 8, WGM = 8;
__host__ __device__ __forceinline__ int lds_byte(int r, int c) { const int st = (r >> 4) * 2 + (c >> 5), rr = r & 15, cc = c & 31, ob = rr * 64 + cc * 2; return st * 1024 + (ob ^ (((ob >> 9) & 1) << 5)); }
__host__ __device__ __forceinline__ void stage_rc(int b, int& R, int& C) { const int st = b / 1024, sb = b % 1024, swz = sb ^ (((sb >> 9) & 1) << 5); R = (st >> 1) * 16 + swz / 64; C = (st & 1) * 32 + (swz % 64) / 2; }
__host__ __device__ __forceinline__ int perm32(int rho) { const int n = rho >> 4, i = rho & 15; return 8 * (i >> 2) + 4 * n + (i & 3); }

struct Unit { const char* A; const char* B; int pm, pn; };
struct Cfg { unsigned lda, ldb; int K; };

struct SchedStd {
    const char* A; const char* B; unsigned lda, ldb; int nM, nN, nwg, G, c;
    DI void init(const void* A_, const void* B_, unsigned lda_, unsigned ldb_, int M, int N, int G_, int c_) { A = (const char*)A_; B = (const char*)B_; lda = lda_; ldb = ldb_; nM = M / BM; nN = N / BM; nwg = nM * nN; G = G_; c = c_; }
    DI bool next(int i, Unit& u) const {
        const long L = (long)i * G + c; if (L >= nwg) return false;
        int wgid = (int)L; { const int q = nwg / NXCD, r = nwg % NXCD, xcd = wgid % NXCD, off = wgid / NXCD; wgid = (xcd < r ? xcd * (q + 1) : r * (q + 1) + (xcd - r) * q) + off; }
        const int nig = WGM * nN, gid = wgid / nig, fm = gid * WGM, gsz = (nM - fm) < WGM ? (nM - fm) : WGM;
        u.pm = fm + ((wgid % nig) % gsz); u.pn = (wgid % nig) / gsz;
        u.A = A + (size_t)u.pm * BM * lda; u.B = B + (size_t)u.pn * BM * ldb; return true;
    }
};

template <bool PERM, class Sched, class Epi>
DI void gemm_phase(LAS unsigned char* lds, const int tid, const Cfg g, const Sched& S, const Epi& E) {
    const int wid = __builtin_amdgcn_readfirstlane(tid >> 6), lane = tid & 63, wr = wid >> 2, wc = wid & 3, fr = lane & 15, fq = lane >> 4;
    const int nt = g.K / BK;
    unsigned voffA[2], voffB[2];
#pragma unroll
    for (int i = 0; i < 2; ++i) { int R, C; stage_rc(tid * 16 + i * 8192, R, C); const int Rb = PERM ? ((R & ~31) + perm32(R & 31)) : R;
        voffA[i] = (unsigned)R * g.lda + (unsigned)C * 2u; voffB[i] = (unsigned)Rb * g.ldb + (unsigned)C * 2u; }
    const size_t kstep = (size_t)(BK * 2);
    const size_t hsA = (size_t)HALF * g.lda, hsB = (size_t)HALF * g.ldb;
    const unsigned ldsw = (unsigned)wid * 1024u;
    const int aoff = lds_byte(wr * 64 + fr, fq * 8), boff = lds_byte(wc * 32 + fr, fq * 8);
#define PG8_SA(b, h) (((b) * 2 + (h)) * HTB)
#define PG8_SB(b, h) ((4 + (b) * 2 + (h)) * HTB)
#define PG8_STAGE(bufoff, gbase, voff) do { const char* _gb = (const char*)(gbase); asm volatile("" : "+s"(_gb));   \
        _Pragma("unroll") for (int _i = 0; _i < 2; ++_i) \
        __builtin_amdgcn_global_load_lds((const unsigned*)(_gb + (voff)[_i]), (LAS unsigned*)(lds + (bufoff) + ldsw + _i * 8192), 16, 0, 0); } while (0)
#define PG8_LDA(dst, b, h) do { _Pragma("unroll") for (int m = 0; m < 4; ++m) _Pragma("unroll") for (int k = 0; k < 2; ++k) dst[m][k] = *(const LAS bf16x8*)(lds + PG8_SA(b, h) + aoff + m * 2048 + k * 1024); } while (0)
#define PG8_LDB(dst, b, h) do { _Pragma("unroll") for (int n = 0; n < 2; ++n) _Pragma("unroll") for (int k = 0; k < 2; ++k) dst[n][k] = *(const LAS bf16x8*)(lds + PG8_SB(b, h) + boff + n * 2048 + k * 1024); } while (0)
#define PG8_MMA(ai, bj, At, Bt) do { __builtin_amdgcn_s_setprio(1); _Pragma("unroll") for (int m = 0; m < 4; ++m) _Pragma("unroll") for (int n = 0; n < 2; ++n) _Pragma("unroll") for (int k = 0; k < 2; ++k) \
        acc[ai][bj][m][n] = __builtin_amdgcn_mfma_f32_16x16x32_bf16(Bt[n][k], At[m][k], acc[ai][bj][m][n], 0, 0, 0); __builtin_amdgcn_s_setprio(0); } while (0)
#define PG8_WAIT_V(n) asm volatile("s_waitcnt vmcnt(" #n ")" ::: "memory")
#define PG8_WAIT_L(n) asm volatile("s_waitcnt lgkmcnt(" #n ")" ::: "memory")
#define PG8_BAR __builtin_amdgcn_s_barrier()
#define PG8_SCHED __builtin_amdgcn_sched_barrier(0)
    Unit cur, nxt; int ui = 0;
    if (!S.next(0, cur)) return;
    f32x4 acc[2][2][4][2];
#pragma unroll
    for (int a = 0; a < 2; ++a)
#pragma unroll
        for (int b = 0; b < 2; ++b)
#pragma unroll
            for (int m = 0; m < 4; ++m)
#pragma unroll
                for (int n = 0; n < 2; ++n) acc[a][b][m][n] = (f32x4){0.f, 0.f, 0.f, 0.f};
    bf16x8 At[4][2], B0[2][2], B1[2][2];
    const char* cA = cur.A; const char* cB = cur.B;
    PG8_STAGE(PG8_SB(0, 0), cB, voffB); PG8_STAGE(PG8_SB(0, 1), cB + hsB, voffB); PG8_STAGE(PG8_SA(0, 0), cA, voffA); PG8_STAGE(PG8_SA(0, 1), cA + hsA, voffA);
    if (wr == 1) PG8_BAR;
    PG8_WAIT_V(2); PG8_BAR;
    PG8_STAGE(PG8_SB(1, 0), cB + kstep, voffB); PG8_STAGE(PG8_SA(1, 0), cA + kstep, voffA); PG8_STAGE(PG8_SB(1, 1), cB + hsB + kstep, voffB);
    PG8_WAIT_V(6); PG8_BAR;
    for (;;) {
        const bool has_next = S.next(ui + 1, nxt);
        const char* nA = has_next ? nxt.A : cA; const char* nB = has_next ? nxt.B : cB;
        for (int t = 0; t < nt; t += 2) {
            const bool last = (t == nt - 2);
            const char* a1 = cA + (size_t)(t + 1) * kstep;
            const char* a2 = last ? nA : cA + (size_t)(t + 2) * kstep; const char* b2 = last ? nB : cB + (size_t)(t + 2) * kstep;
            const char* a3 = a2 + kstep; const char* b3 = b2 + kstep;
            PG8_LDB(B0, 0, 0); PG8_LDB(B1, 0, 1); PG8_SCHED; PG8_LDA(At, 0, 0); PG8_STAGE(PG8_SA(1, 1), a1 + hsA, voffA);
            PG8_WAIT_V(8); PG8_WAIT_L(0); PG8_BAR; PG8_MMA(0, 0, At, B0); PG8_MMA(0, 1, At, B1); PG8_BAR; PG8_SCHED;
            PG8_LDA(At, 0, 1); PG8_STAGE(PG8_SB(0, 0), b2, voffB); PG8_STAGE(PG8_SB(0, 1), b2 + hsB, voffB); PG8_STAGE(PG8_SA(0, 0), a2, voffA);
            PG8_WAIT_V(8); PG8_WAIT_L(0); PG8_BAR; PG8_MMA(1, 0, At, B0); PG8_MMA(1, 1, At, B1); PG8_BAR; PG8_SCHED;
            PG8_LDB(B0, 1, 0); PG8_LDB(B1, 1, 1); PG8_SCHED; PG8_LDA(At, 1, 0); PG8_STAGE(PG8_SA(0, 1), a2 + hsA, voffA);
            PG8_WAIT_V(8); PG8_WAIT_L(0); PG8_BAR; PG8_MMA(0, 0, At, B0); PG8_MMA(0, 1, At, B1); PG8_BAR; PG8_SCHED;
            PG8_LDA(At, 1, 1); PG8_STAGE(PG8_SB(1, 0), b3, voffB); PG8_STAGE(PG8_SB(1, 1), b3 + hsB, voffB); PG8_STAGE(PG8_SA(1, 0), a3, voffA);
            PG8_WAIT_V(8); PG8_WAIT_L(0); PG8_BAR; PG8_MMA(1, 0, At, B0); PG8_MMA(1, 1, At, B1); PG8_BAR; PG8_SCHED;
        }
        if (wr == 0) PG8_BAR;
        E(acc, cur, wr, wc, fr, fq);
        if (!has_next) break;
#pragma unroll
        for (int a = 0; a < 2; ++a)
#pragma unroll
            for (int b = 0; b < 2; ++b)
#pragma unroll
                for (int m = 0; m < 4; ++m)
#pragma unroll
                    for (int n = 0; n < 2; ++n) acc[a][b][m][n] = (f32x4){0.f, 0.f, 0.f, 0.f};
        cur = nxt; cA = nA; cB = nB; ++ui;
        if (wr == 1) PG8_BAR;
    }
    PG8_WAIT_V(0);
    PG8_BAR;
#undef PG8_SA
#undef PG8_SB
#undef PG8_STAGE
#undef PG8_LDA
#undef PG8_LDB
#undef PG8_MMA
#undef PG8_WAIT_V
#undef PG8_WAIT_L
#undef PG8_BAR
#undef PG8_SCHED
}

template <bool PERM, class Sched, class Epi>
DI void gemm_phase_hn(LAS unsigned char* lds, const int tid, const Cfg g, const Sched& S, const Epi& E) {
    const int wid = __builtin_amdgcn_readfirstlane(tid >> 6), lane = tid & 63, wr = wid >> 2, wc = wid & 3, fr = lane & 15, fq = lane >> 4;
    const int nt = g.K / BK;
    unsigned voffA[2], voffB[2];
#pragma unroll
    for (int i = 0; i < 2; ++i) { int R, C; stage_rc(tid * 16 + i * 8192, R, C); const int Rb = PERM ? ((R & ~31) + perm32(R & 31)) : R;
        voffA[i] = (unsigned)R * g.lda + (unsigned)C * 2u; voffB[i] = (unsigned)Rb * g.ldb + (unsigned)C * 2u; }
    const size_t kstep = (size_t)(BK * 2);
    const size_t hsA = (size_t)HALF * g.lda;
    const unsigned ldsw = (unsigned)wid * 1024u;
    const int aoff = lds_byte(wr * 64 + fr, fq * 8), boff = lds_byte(wc * 32 + fr, fq * 8);
#define PG8_SA(b, h) (((b) * 2 + (h)) * HTB)
#define PG8_SB(b, h) ((4 + (b) * 2 + (h)) * HTB)
#define PG8_STAGE(bufoff, gbase, voff) do { const char* _gb = (const char*)(gbase); asm volatile("" : "+s"(_gb));   \
        _Pragma("unroll") for (int _i = 0; _i < 2; ++_i) \
        __builtin_amdgcn_global_load_lds((const unsigned*)(_gb + (voff)[_i]), (LAS unsigned*)(lds + (bufoff) + ldsw + _i * 8192), 16, 0, 0); } while (0)
#define PG8_LDA(dst, b, h) do { _Pragma("unroll") for (int m = 0; m < 4; ++m) _Pragma("unroll") for (int k = 0; k < 2; ++k) dst[m][k] = *(const LAS bf16x8*)(lds + PG8_SA(b, h) + aoff + m * 2048 + k * 1024); } while (0)
#define PG8_LDB(dst, b, h) do { _Pragma("unroll") for (int n = 0; n < 2; ++n) _Pragma("unroll") for (int k = 0; k < 2; ++k) dst[n][k] = *(const LAS bf16x8*)(lds + PG8_SB(b, h) + boff + n * 2048 + k * 1024); } while (0)
#define PG8_MMA(ai, bj, At, Bt) do { __builtin_amdgcn_s_setprio(1); _Pragma("unroll") for (int m = 0; m < 4; ++m) _Pragma("unroll") for (int n = 0; n < 2; ++n) _Pragma("unroll") for (int k = 0; k < 2; ++k) \
        acc[ai][bj][m][n] = __builtin_amdgcn_mfma_f32_16x16x32_bf16(Bt[n][k], At[m][k], acc[ai][bj][m][n], 0, 0, 0); __builtin_amdgcn_s_setprio(0); } while (0)
#define PG8_WAIT_V(n) asm volatile("s_waitcnt vmcnt(" #n ")" ::: "memory")
#define PG8_WAIT_L(n) asm volatile("s_waitcnt lgkmcnt(" #n ")" ::: "memory")
#define PG8_BAR __builtin_amdgcn_s_barrier()
#define PG8_SCHED __builtin_amdgcn_sched_barrier(0)
    Unit cur, nxt; int ui = 0;
    if (!S.next(0, cur)) return;
    f32x4 acc[2][1][4][2];
#pragma unroll
    for (int a = 0; a < 2; ++a)
#pragma unroll
        for (int b = 0; b < 1; ++b)
#pragma unroll
            for (int m = 0; m < 4; ++m)
#pragma unroll
                for (int n = 0; n < 2; ++n) acc[a][b][m][n] = (f32x4){0.f, 0.f, 0.f, 0.f};
    bf16x8 At[4][2], B0[2][2];
    const char* cA = cur.A; const char* cB = cur.B;
    PG8_STAGE(PG8_SB(0, 0), cB, voffB); PG8_STAGE(PG8_SA(0, 0), cA, voffA); PG8_STAGE(PG8_SA(0, 1), cA + hsA, voffA);
    if (wr == 1) PG8_BAR;
    PG8_WAIT_V(2); PG8_BAR;
    PG8_STAGE(PG8_SB(1, 0), cB + kstep, voffB); PG8_STAGE(PG8_SA(1, 0), cA + kstep, voffA);
    PG8_WAIT_V(4); PG8_BAR;
    for (;;) {
        const bool has_next = S.next(ui + 1, nxt);
        const char* nA = has_next ? nxt.A : cA; const char* nB = has_next ? nxt.B : cB;
        for (int t = 0; t < nt; t += 2) {
            const bool last = (t == nt - 2);
            const char* a1 = cA + (size_t)(t + 1) * kstep;
            const char* a2 = last ? nA : cA + (size_t)(t + 2) * kstep; const char* b2 = last ? nB : cB + (size_t)(t + 2) * kstep;
            const char* a3 = a2 + kstep; const char* b3 = b2 + kstep;
            PG8_LDB(B0, 0, 0); PG8_SCHED; PG8_LDA(At, 0, 0); PG8_STAGE(PG8_SA(1, 1), a1 + hsA, voffA);
            PG8_WAIT_V(6); PG8_WAIT_L(0); PG8_BAR; PG8_MMA(0, 0, At, B0); PG8_BAR; PG8_SCHED;
            PG8_LDA(At, 0, 1); PG8_STAGE(PG8_SB(0, 0), b2, voffB); PG8_STAGE(PG8_SA(0, 0), a2, voffA);
            PG8_WAIT_V(6); PG8_WAIT_L(0); PG8_BAR; PG8_MMA(1, 0, At, B0); PG8_BAR; PG8_SCHED;
            PG8_LDB(B0, 1, 0); PG8_SCHED; PG8_LDA(At, 1, 0); PG8_STAGE(PG8_SA(0, 1), a2 + hsA, voffA);
            PG8_WAIT_V(6); PG8_WAIT_L(0); PG8_BAR; PG8_MMA(0, 0, At, B0); PG8_BAR; PG8_SCHED;
            PG8_LDA(At, 1, 1); PG8_STAGE(PG8_SB(1, 0), b3, voffB); PG8_STAGE(PG8_SA(1, 0), a3, voffA);
            PG8_WAIT_V(6); PG8_WAIT_L(0); PG8_BAR; PG8_MMA(1, 0, At, B0); PG8_BAR; PG8_SCHED;
        }
        if (wr == 0) PG8_BAR;
        E(acc, cur, wr, wc, fr, fq);
        if (!has_next) break;
#pragma unroll
        for (int a = 0; a < 2; ++a)
#pragma unroll
            for (int b = 0; b < 1; ++b)
#pragma unroll
                for (int m = 0; m < 4; ++m)
#pragma unroll
                    for (int n = 0; n < 2; ++n) acc[a][b][m][n] = (f32x4){0.f, 0.f, 0.f, 0.f};
        cur = nxt; cA = nA; cB = nB; ++ui;
        if (wr == 1) PG8_BAR;
    }
    PG8_WAIT_V(0);
    PG8_BAR;
#undef PG8_SA
#undef PG8_SB
#undef PG8_STAGE
#undef PG8_LDA
#undef PG8_LDB
#undef PG8_MMA
#undef PG8_WAIT_V
#undef PG8_WAIT_L
#undef PG8_BAR
#undef PG8_SCHED
}

typedef f32x4 Acc[2][2][4][2];
struct EpiStore {
    bf16_t* O; unsigned ldc;
    DI void operator()(const Acc& acc, const Unit& u, int wr, int wc, int fr, int fq) const {
        asm volatile("" : "+v"(fr), "+v"(fq));
        const int row0 = u.pm * BM + wr * 64 + fr, col0 = u.pn * BM + wc * 32 + 8 * fq;
#pragma unroll
        for (int ai = 0; ai < 2; ++ai)
#pragma unroll
            for (int m = 0; m < 4; ++m) { bf16_t* rowp = O + (size_t)(row0 + ai * HALF + m * 16) * ldc + col0;
#pragma unroll
                for (int bj = 0; bj < 2; ++bj) { const f32x4 v0 = acc[ai][bj][m][0], v1 = acc[ai][bj][m][1];
                    u32x4 w; w.x = cvt_pk_bf16(v0[0], v0[1]); w.y = cvt_pk_bf16(v0[2], v0[3]); w.z = cvt_pk_bf16(v1[0], v1[1]); w.w = cvt_pk_bf16(v1[2], v1[3]);
                    *(u32x4*)(rowp + bj * HALF) = w; } }
    }
};
struct EpiSwiglu {
    bf16_t* O;
    DI void operator()(const Acc& acc, const Unit& u, int wr, int wc, int fr, int fq) const {
        asm volatile("" : "+v"(fr), "+v"(fq));
        const int row0 = u.pm * BM + wr * 64 + fr, col0 = u.pn * HALF + wc * 32 + 8 * fq;
#pragma unroll
        for (int ai = 0; ai < 2; ++ai)
#pragma unroll
            for (int m = 0; m < 4; ++m) { bf16_t* rowp = O + (size_t)(row0 + ai * HALF + m * 16) * FF + col0;
                float r[8];
#pragma unroll
                for (int n = 0; n < 2; ++n)
#pragma unroll
                    for (int j = 0; j < 4; ++j) { const float gv = acc[ai][0][m][n][j], uv = acc[ai][1][m][n][j]; r[n * 4 + j] = gv * __builtin_amdgcn_rcpf(1.f + __expf(-gv)) * uv; }
                u32x4 w; w.x = cvt_pk_bf16(r[0], r[1]); w.y = cvt_pk_bf16(r[2], r[3]); w.z = cvt_pk_bf16(r[4], r[5]); w.w = cvt_pk_bf16(r[6], r[7]);
                *(u32x4*)rowp = w; }
    }
};
template <bool IN32> DI f32x4 ld_h(const void* base, size_t off) {
    if constexpr (IN32) return *(const f32x4*)((const float*)base + off);
    else { const u32x2 w = *(const u32x2*)((const bf16_t*)base + off); return (f32x4){bflo(w.x), bfhi(w.x), bflo(w.y), bfhi(w.y)}; } }
template <bool OUT32> DI void st_h(void* base, size_t off, const f32x4 v) {
    if constexpr (OUT32) *(f32x4*)((float*)base + off) = v;
    else { u32x2 w; w.x = cvt_pk_bf16(v[0], v[1]); w.y = cvt_pk_bf16(v[2], v[3]); *(u32x2*)((bf16_t*)base + off) = w; } }
template <bool IN32, bool OUT32> struct EpiResid {
    const void* hin0; const void* hin1; void* hout; const float* gate; float coef;
    DI void operator()(const Acc& acc, const Unit& u, int wr, int wc, int fr, int fq) const {
        asm volatile("" : "+v"(fr), "+v"(fq));
        const int trow = u.pm * BM; const int cond = trow < T_CTX ? 0 : 1 + ((trow - T_CTX) >> 12);
        const size_t isz = IN32 ? 4 : 2, osz = OUT32 ? 4 : 2;
        const char* hin = trow < T_CTX ? (const char*)hin0 + (size_t)trow * DM * isz : (const char*)hin1 + (size_t)(trow - T_CTX) * DM * isz;
        char* ho = (char*)hout + (size_t)trow * DM * osz;
        const int r0 = wr * 64 + fr, col0 = u.pn * BM + wc * 32 + 4 * fq;
        const float* gp = gate + (size_t)cond * (NMOD * DM) + col0;
        f32x4 gv[2][2];
#pragma unroll
        for (int bj = 0; bj < 2; ++bj)
#pragma unroll
            for (int n = 0; n < 2; ++n) gv[bj][n] = *(const f32x4*)(gp + bj * HALF + n * 16) * coef;
#pragma unroll
        for (int ai = 0; ai < 2; ++ai)
#pragma unroll
            for (int m = 0; m < 4; ++m) { const size_t off = (size_t)(r0 + ai * HALF + m * 16) * DM + col0;
#pragma unroll
                for (int bj = 0; bj < 2; ++bj)
#pragma unroll
                    for (int n = 0; n < 2; ++n) { const f32x4 hv = ld_h<IN32>(hin, off + bj * HALF + n * 16);
                        st_h<OUT32>(ho, off + bj * HALF + n * 16, hv + gv[bj][n] * acc[ai][bj][m][n]); }
                asm volatile("" ::: "memory"); }
    }
};
typedef f32x4 AccH[2][1][4][2];
template <bool IN32, bool OUT32> struct EpiResidHN {
    const void* hin0; const void* hin1; void* hout; const float* gate; float coef;
    DI void operator()(const AccH& acc, const Unit& u, int wr, int wc, int fr, int fq) const {
        asm volatile("" : "+v"(fr), "+v"(fq));
        const int trow = u.pm * BM; const int cond = trow < T_CTX ? 0 : 1 + ((trow - T_CTX) >> 12);
        const size_t isz = IN32 ? 4 : 2, osz = OUT32 ? 4 : 2;
        const char* hin = trow < T_CTX ? (const char*)hin0 + (size_t)trow * DM * isz : (const char*)hin1 + (size_t)(trow - T_CTX) * DM * isz;
        char* ho = (char*)hout + (size_t)trow * DM * osz;
        const int r0 = wr * 64 + fr, col0 = u.pn * HALF + wc * 32 + 4 * fq;
        const float* gp = gate + (size_t)cond * (NMOD * DM) + col0;
        f32x4 gv[2];
#pragma unroll
        for (int n = 0; n < 2; ++n) gv[n] = *(const f32x4*)(gp + n * 16) * coef;
#pragma unroll
        for (int ai = 0; ai < 2; ++ai)
#pragma unroll
            for (int m = 0; m < 4; ++m) { const size_t off = (size_t)(r0 + ai * HALF + m * 16) * DM + col0;
#pragma unroll
                for (int n = 0; n < 2; ++n) { const f32x4 hv = ld_h<IN32>(hin, off + n * 16);
                    st_h<OUT32>(ho, off + n * 16, hv + gv[n] * acc[ai][0][m][n]); }
                asm volatile("" ::: "memory"); }
    }
};
struct EpiStoreHN {
    bf16_t* O0; unsigned ldc0; ptrdiff_t dO1; unsigned ldc1;
    DI void operator()(const AccH& acc, const Unit& u, int wr, int wc, int fr, int fq) const {
        asm volatile("" : "+v"(fr), "+v"(fq));
        const bool second = u.pn >= 256;
        bf16_t* O = (bf16_t*)((char*)O0 + (second ? dO1 : (ptrdiff_t)0)); const unsigned ldc = second ? ldc1 : ldc0;
        const int row0 = u.pm * BM + wr * 64 + fr, col0 = u.pn * HALF + wc * 32 + 8 * fq;
#pragma unroll
        for (int ai = 0; ai < 2; ++ai)
#pragma unroll
            for (int m = 0; m < 4; ++m) { bf16_t* rowp = O + (size_t)(row0 + ai * HALF + m * 16) * ldc + col0;
                const f32x4 v0 = acc[ai][0][m][0], v1 = acc[ai][0][m][1];
                u32x4 w; w.x = cvt_pk_bf16(v0[0], v0[1]); w.y = cvt_pk_bf16(v0[2], v0[3]); w.z = cvt_pk_bf16(v1[0], v1[1]); w.w = cvt_pk_bf16(v1[2], v1[3]);
                *(u32x4*)rowp = w; }
    }
};
struct SchedWinTail {
    const char* XN; const char* WIN; const char* WINF; int G, c;
    DI bool next(int i, Unit& u) const { const int L = i * G + c; if (L >= 198) return false;
        if (L < 70) { u.pm = 153 + L / 10; u.pn = L % 10; u.A = XN + (size_t)u.pm * BM * (DM * 2); u.B = WIN + (size_t)u.pn * HALF * (DM * 2); }
        else { const int t = L - 70; u.pm = t & 1; u.pn = 256 + (t >> 1); u.A = WINF + (size_t)u.pm * BM * (DM * 2); u.B = XN + (size_t)u.pn * HALF * (DM * 2); }
        return true; }
};
struct SchedHN {
    const char* A; const char* B; unsigned lda, ldb; int G, c;
    DI bool next(int i, Unit& u) const { const int L = i * G + c; if (L >= 256) return false; const int xcd = L & 7, slot = L >> 3;
        u.pm = 128 + xcd * 4 + (slot >> 3); u.pn = slot & 7;
        u.A = A + (size_t)u.pm * BM * lda; u.B = B + (size_t)u.pn * HALF * ldb; return true; }
};
struct EpiGlu {
    const bf16_t* YS; const float* bias; bf16_t* O;
    DI void operator()(const Acc& acc, const Unit& u, int wr, int wc, int fr, int fq) const {
        asm volatile("" : "+v"(fr), "+v"(fq));
        const int row0 = u.pm * BM + wr * 64 + fr, col0 = wc * 32 + 8 * fq;
#pragma unroll
        for (int ai = 0; ai < 2; ++ai)
#pragma unroll
            for (int m = 0; m < 4; ++m) { const int row = row0 + ai * HALF + m * 16;
#pragma unroll
                for (int bj = 0; bj < 2; ++bj) {
                    const f32x4 b0 = *(const f32x4*)(bias + col0 + bj * HALF), b1 = *(const f32x4*)(bias + col0 + bj * HALF + 4);
                    const u32x4 yv = *(const u32x4*)(YS + (size_t)row * 256 + col0 + bj * HALF);
                    const f32x4 v0 = acc[ai][bj][m][0] + b0, v1 = acc[ai][bj][m][1] + b1;
                    u32x4 w;
                    w.x = cvt_pk_bf16(bflo(yv.x) * sigmoid_f(v0[0]), bfhi(yv.x) * sigmoid_f(v0[1])); w.y = cvt_pk_bf16(bflo(yv.y) * sigmoid_f(v0[2]), bfhi(yv.y) * sigmoid_f(v0[3]));
                    w.z = cvt_pk_bf16(bflo(yv.z) * sigmoid_f(v1[0]), bfhi(yv.z) * sigmoid_f(v1[1])); w.w = cvt_pk_bf16(bflo(yv.w) * sigmoid_f(v1[2]), bfhi(yv.w) * sigmoid_f(v1[3]));
                    *(u32x4*)(O + (size_t)row * DM + col0 + bj * HALF) = w;
                    asm volatile("" ::: "memory"); } }
    }
};
struct EpiBias {
    const float* bias; bf16_t* O; int cbase;
    DI void operator()(const Acc& acc, const Unit& u, int wr, int wc, int fr, int fq) const {
        asm volatile("" : "+v"(fr), "+v"(fq));
        const int row0 = u.pm * BM + wr * 64 + fr, col0 = wc * 32 + 8 * fq;
#pragma unroll
        for (int ai = 0; ai < 2; ++ai)
#pragma unroll
            for (int m = 0; m < 4; ++m) { const int row = row0 + ai * HALF + m * 16;
#pragma unroll
                for (int bj = 0; bj < 2; ++bj) {
                    const f32x4 b0 = *(const f32x4*)(bias + col0 + bj * HALF), b1 = *(const f32x4*)(bias + col0 + bj * HALF + 4);
                    const f32x4 v0 = acc[ai][bj][m][0] + b0, v1 = acc[ai][bj][m][1] + b1;
                    u32x4 w; w.x = cvt_pk_bf16(v0[0], v0[1]); w.y = cvt_pk_bf16(v0[2], v0[3]); w.z = cvt_pk_bf16(v1[0], v1[1]); w.w = cvt_pk_bf16(v1[2], v1[3]);
                    *(u32x4*)(O + (size_t)row * DM + cbase + col0 + bj * HALF) = w;
                    asm volatile("" ::: "memory"); } }
    }
};
struct SchedDftLat {
    const char* TC; size_t dT; const char* PQT; int G, c;
    DI bool next(int i, Unit& u) const { const int L = i * G + c; if (L >= 256) return false; const int part = L & 3, mt = (L >> 2) & 7, b = L >> 5, cs = part >> 1, kh = part & 1;
        u.A = TC + (size_t)cs * dT + (size_t)(1 + 256 * mt) * 8192 + (size_t)kh * 4096; u.B = PQT + (size_t)cs * 256 * (T_ALL * 2) + (size_t)(T_CTX + b * 4096 + kh * 2048) * 2;
        u.pm = b * 8 + mt; u.pn = part; return true; }
};
struct SchedDftCtx {
    const char* TC; size_t dT; const char* PQT; int G, c;
    DI bool next(int i, Unit& u) const { const int L = i * G + (c + G / 4) % G; if (L >= 64) return false; const int half = L & 1, b = L >> 1;
        u.A = TC + (size_t)half * dT; u.B = PQT + (size_t)half * 256 * (T_ALL * 2) + (size_t)(b * 256) * 2;
        u.pm = b; u.pn = half; return true; }
};
struct EpiDftSym {
    bf16_t* O;
    DI void operator()(const Acc& acc, const Unit& u, int wr, int wc, int fr, int fq) const {
        asm volatile("" : "+v"(fr), "+v"(fq));
        const int b = u.pm >> 3, mt = u.pm & 7, part = u.pn; const unsigned sgn = (part >> 1) ? 0x80008000u : 0u;
        bf16_t* base = O + (size_t)(T_CTX + b * 4096) * 1024 + part * 256 + wc * 32 + 8 * fq;
        const int lp0 = 1 + 256 * mt + wr * 64 + fr;
#pragma unroll
        for (int ai = 0; ai < 2; ++ai)
#pragma unroll
            for (int m = 0; m < 4; ++m) { const int lp = lp0 + ai * HALF + m * 16;
#pragma unroll
                for (int bj = 0; bj < 2; ++bj) { const f32x4 v0 = acc[ai][bj][m][0], v1 = acc[ai][bj][m][1];
                    u32x4 w; w.x = cvt_pk_bf16(v0[0], v0[1]); w.y = cvt_pk_bf16(v0[2], v0[3]); w.z = cvt_pk_bf16(v1[0], v1[1]); w.w = cvt_pk_bf16(v1[2], v1[3]);
                    *(u32x4*)(base + (unsigned)(lp * 1024 + bj * HALF)) = w;
                    w.x ^= sgn; w.y ^= sgn; w.z ^= sgn; w.w ^= sgn;
                    *(u32x4*)(base + (unsigned)((4096 - lp) * 1024 + bj * HALF)) = w;
                    asm volatile("" ::: "memory"); } }
    }
};
struct EpiDftCtx {
    bf16_t* O;
    DI void operator()(const Acc& acc, const Unit& u, int wr, int wc, int fr, int fq) const {
        asm volatile("" : "+v"(fr), "+v"(fq));
        const int row0 = u.pm * BM + wr * 64 + fr, col0 = u.pn * 512 + wc * 32 + 8 * fq;
#pragma unroll
        for (int ai = 0; ai < 2; ++ai)
#pragma unroll
            for (int m = 0; m < 4; ++m) { bf16_t* rowp = O + (size_t)(row0 + ai * HALF + m * 16) * 1024 + col0;
#pragma unroll
                for (int bj = 0; bj < 2; ++bj) { const f32x4 v0 = acc[ai][bj][m][0], v1 = acc[ai][bj][m][1];
                    u32x4 w; w.x = cvt_pk_bf16(v0[0], v0[1]); w.y = cvt_pk_bf16(v0[2], v0[3]); w.z = cvt_pk_bf16(v1[0], v1[1]); w.w = cvt_pk_bf16(v1[2], v1[3]);
                    *(u32x4*)(rowp + bj * HALF) = w; *(u32x4*)(rowp + 256 + bj * HALF) = (u32x4){0u, 0u, 0u, 0u}; } }
    }
};
}

constexpr int PTAB_OFF = 131072;
struct InTab { const unsigned char* lds;
    DI const float* operator[](int k) const { const u32x2 v = *(const u32x2*)(lds + PTAB_OFF + 8 * k);
        const unsigned long long p = ((unsigned long long)(unsigned)__builtin_amdgcn_readfirstlane((int)v.y) << 32) | (unsigned)__builtin_amdgcn_readfirstlane((int)v.x); return (const float*)(const __attribute__((address_space(1))) float*)p; } };
struct Frame {
    unsigned char* lds; LAS unsigned char* ldsl;
    int tid, lane, wave, G, bid;
    InTab in; float* out; unsigned char* ws;
};
DI Frame mkframe(unsigned char* lds, int wv) {
    Frame F; F.lds = lds; F.ldsl = (LAS unsigned char*)lds;
    asm volatile("" : "+s"(wv));
    unsigned z = 0u; asm volatile("v_mov_b32 %0, 0" : "=v"(z));
    int tid = wv * 64 + (int)__builtin_amdgcn_mbcnt_hi(~0u, __builtin_amdgcn_mbcnt_lo(~0u, z)); asm volatile("" : "+v"(tid));
    F.tid = tid; F.lane = tid & 63; F.wave = __builtin_amdgcn_readfirstlane(tid >> 6);
    int g = gridDim.x, b = blockIdx.x; asm volatile("" : "+s"(g), "+s"(b)); F.G = g; F.bid = b;
    F.in.lds = lds; F.out = (float*)F.in[36]; F.ws = (unsigned char*)F.in[37];
    return F;
}


#define XB_TMO      128
#define XB_XCNT(j)  (256  + 64 * (j))
#define XB_XSUB(j)  (1280 + 64 * (j))
#define XB_XGEN(j)  (2304 + 64 * (j))
#define XB_TOP      3328
#define XB_TOPGEN   3392
#define XB_SPIN_CAP (1u << 20)
constexpr int XBST_OFF = PTAB_OFF + 512;
DI unsigned xb_ld(unsigned* p)              { return __hip_atomic_load(p, __ATOMIC_RELAXED, __HIP_MEMORY_SCOPE_AGENT); }
DI unsigned xb_add(unsigned* p, unsigned v) { return __hip_atomic_fetch_add(p, v, __ATOMIC_RELAXED, __HIP_MEMORY_SCOPE_AGENT); }
DI unsigned xb_xcc_id() { return (unsigned)__builtin_amdgcn_s_getreg((3 << 11) | 20) & 0xFu; }
#define XB_SPIN(cond, bar) do { unsigned _sp = 0; while (cond) { __builtin_amdgcn_s_sleep(1); \
    if ((++_sp & 255u) == 0u) { if (xb_ld(&(bar)[XB_TMO])) break; if (_sp > XB_SPIN_CAP) { atomicAdd(&(bar)[XB_TMO], 1u); break; } } } } while (0)
DI void xcd_barrier_complete(unsigned* bar, unsigned x, unsigned& nloc, unsigned& nx) {
    const unsigned G = gridDim.x;
    unsigned sum, cnt, mine, sp = 0u;
    for (;;) {
        sum = 0u; cnt = 0u; mine = 0u;
#pragma unroll
        for (unsigned j = 0; j < 16; ++j) { const unsigned c = xb_ld(&bar[XB_XCNT(j)]); sum += c; cnt += (c > 0u) ? 1u : 0u; mine = (j == x) ? c : mine; }
        if (sum == G) break;
        __builtin_amdgcn_s_sleep(1);
        if ((++sp & 255u) == 0u) { if (xb_ld(&bar[XB_TMO])) break; if (sp > XB_SPIN_CAP) { atomicAdd(&bar[XB_TMO], 1u); break; } }
    }
    nloc = mine > 0u ? mine : 1u; nx = cnt > 0u ? cnt : 1u;
}
DI void xcd_sync(unsigned char* lds, int wv) {
    asm volatile("s_waitcnt vmcnt(0) lgkmcnt(0)" ::: "memory");
    __syncthreads();
    asm volatile("" : "+s"(wv));
    if (wv == 0) {
        unsigned z = 0u; asm volatile("v_mov_b32 %0, 0" : "=v"(z));
        const unsigned lane = __builtin_amdgcn_mbcnt_hi(~0u, __builtin_amdgcn_mbcnt_lo(~0u, z));
        if (lane == 0) {
            InTab in; in.lds = lds; unsigned* bar = (unsigned*)((unsigned char*)in[37] + OFF_CTL);
            volatile unsigned* st = (volatile unsigned*)(lds + XBST_OFF);
            const unsigned x = xb_xcc_id();
            __builtin_amdgcn_s_waitcnt(0);
            unsigned nloc = st[0], nx = st[1];
            if (nloc == 0u) { xcd_barrier_complete(bar, x, nloc, nx); st[0] = nloc; st[1] = nx; }
            const unsigned old = xb_add(&bar[XB_XSUB(x)], 1u);
            const unsigned gen = old / nloc;
            if (old + 1u == (gen + 1u) * nloc) {
                __builtin_amdgcn_fence(__ATOMIC_RELEASE, "agent");
                asm volatile("s_waitcnt vmcnt(0)" ::: "memory");
                const unsigned og = xb_add(&bar[XB_TOP], 1u);
                const unsigned tg = og / nx;
                if (og + 1u == (tg + 1u) * nx) xb_add(&bar[XB_TOPGEN], 1u);
                else XB_SPIN(xb_ld(&bar[XB_TOPGEN]) == tg, bar);
                __builtin_amdgcn_fence(__ATOMIC_ACQUIRE, "agent");
                xb_add(&bar[XB_XGEN(x)], 1u);
                asm volatile("s_waitcnt vmcnt(0)" ::: "memory");
            } else {
                XB_SPIN(xb_ld(&bar[XB_XGEN(x)]) == gen, bar);
                __builtin_amdgcn_fence(__ATOMIC_ACQUIRE, "agent");
                asm volatile("s_waitcnt vmcnt(0)" ::: "memory");
            }
        }
    }
    __syncthreads();
}

DI void transpose_item(const float* W, int ldw, int k0, int n0, bf16_t* WT, int ldt, int drow0, int dk0, int dk1, float* scr, int lane) {
    { float tv[32];
#pragma unroll
      for (int i = 0; i < 32; ++i) tv[i] = W[(size_t)(k0 + 2 * i + (lane >> 5)) * ldw + n0 + (lane & 31)];
#pragma unroll
      for (int i = 0; i < 32; ++i) scr[(2 * i + (lane >> 5)) * 33 + (lane & 31)] = tv[i]; }
    asm volatile("" ::: "memory"); __builtin_amdgcn_wave_barrier(); asm volatile("" ::: "memory"); asm volatile("s_waitcnt lgkmcnt(0)" ::: "memory");
    const int c = lane & 7;
#pragma unroll
    for (int j = 0; j < 4; ++j) { const int n = (lane >> 3) + 8 * j; const float* s = scr + (8 * c) * 33 + n;
        u32x4 o; o.x = cvt_pk_bf16(s[0 * 33], s[1 * 33]); o.y = cvt_pk_bf16(s[2 * 33], s[3 * 33]); o.z = cvt_pk_bf16(s[4 * 33], s[5 * 33]); o.w = cvt_pk_bf16(s[6 * 33], s[7 * 33]);
        *(u32x4*)(WT + (size_t)(drow0 + n) * ldt + dk0 + 8 * c) = o;
        if (dk1 >= 0) *(u32x4*)(WT + (size_t)(drow0 + n) * ldt + dk1 + 8 * c) = o; }
    asm volatile("" ::: "memory"); __builtin_amdgcn_wave_barrier(); asm volatile("" ::: "memory"); asm volatile("s_waitcnt lgkmcnt(0)" ::: "memory");
}

DI void p0_phase(unsigned char* lds_, int wv_) {
    Frame F = mkframe(lds_, wv_);
    const int gw = F.bid * NWAVES + F.wave, NGW = F.G * NWAVES;
    {
        float* scr = (float*)(F.lds + F.wave * 8704);
        constexpr int PER_L = 6 * 1408 + 640 + 512 + 32 + 32;
        for (int it = gw; it < 2 * PER_L; it += NGW) {
            const int l = it / PER_L; int r = it % PER_L;
            if (r < 6 * 1408) { const int j = r / 1408, q = r % 1408, f = j / 3, t = j % 3;
                const float* W = F.in[12 + j] + (size_t)l * DM * FF;
                if (t < 2) { const int kb = q / 88, nb = q % 88, n0 = 32 * nb;
                    transpose_item(W, FF, 64 * kb, n0, (bf16_t*)(F.ws + OFF_WGU + (size_t)(l * 2 + f) * SZ_WGU), DM, (n0 >> 7) * 256 + (n0 & 127) + (t ? 128 : 0), 64 * kb, -1, scr, F.lane); }
                else { const int kb = q / 32, nb = q % 32;
                    transpose_item(W, DM, 64 * kb, 32 * nb, (bf16_t*)(F.ws + OFF_WDN + (size_t)(l * 2 + f) * SZ_WDN), FF, 32 * nb, 64 * kb, -1, scr, F.lane); }
                continue; }
            r -= 6 * 1408;
            if (r < 640) { const int kb = r / 40, nb = r % 40;
                transpose_item(F.in[18] + (size_t)l * DM * 1536, 1536, 64 * kb, 32 * nb, (bf16_t*)(F.ws + OFF_WIN + (size_t)l * NPROJ * DM * 2), DM, 32 * nb, 64 * kb, -1, scr, F.lane); continue; }
            r -= 640;
            if (r < 512) { const int kb = r / 32, nb = r % 32;
                transpose_item(F.in[19] + (size_t)l * DM * DM, DM, 64 * kb, 32 * nb, (bf16_t*)(F.ws + OFF_WOUT + (size_t)l * DM * DM * 2), DM, 32 * nb, 64 * kb, -1, scr, F.lane); continue; }
            r -= 512;
            if (r < 32) { const int kb = r / 8, nb = r % 8;
                transpose_item(F.in[28] + (size_t)l * 65536, 256, 64 * kb, 32 * nb, (bf16_t*)(F.ws + OFF_WGLU + (size_t)l * 65536 * 2), 256, 32 * nb, 64 * kb, -1, scr, F.lane); continue; }
            r -= 32;
            { const int kb = r / 8, nb = r % 8;
                transpose_item(F.in[33] + (size_t)l * 65536, 256, 64 * kb, 32 * nb, (bf16_t*)(F.ws + OFF_WFN + (size_t)l * 256 * 1024 * 2), 1024, 32 * nb, 64 * kb, 64 * kb + 256, scr, F.lane);
                transpose_item(F.in[33] + (size_t)l * 65536, 256, 64 * kb, 32 * nb, (bf16_t*)(F.ws + OFF_WFN + (size_t)l * 256 * 1024 * 2), 1024, 32 * nb, 64 * kb + 512, 64 * kb + 768, scr, F.lane); }
        }
    }
    __syncthreads();
    float* tab = (float*)(F.lds);
    for (int j = F.tid; j < 4096; j += NTHREADS) tab[j] = cospif((float)j * (1.0f / 2048.0f));
    __syncthreads();
    {
        bf16_t* TC4 = (bf16_t*)(F.ws + OFF_TC4); bf16_t* TS4 = (bf16_t*)(F.ws + OFF_TS4);
        for (int rr = F.bid; rr < 2049; rr += F.G) {
            const int l0 = 8 * F.tid; float cv[8], sv[8];
#pragma unroll
            for (int j = 0; j < 8; ++j) { const int idx = (rr * (l0 + j)) & 4095; cv[j] = tab[idx] * (1.f / 64.f); sv[j] = -tab[(idx - 1024) & 4095] * (1.f / 64.f); }
            u32x4 a, b; a.x = cvt_pk_bf16(cv[0], cv[1]); a.y = cvt_pk_bf16(cv[2], cv[3]); a.z = cvt_pk_bf16(cv[4], cv[5]); a.w = cvt_pk_bf16(cv[6], cv[7]);
            b.x = cvt_pk_bf16(sv[0], sv[1]); b.y = cvt_pk_bf16(sv[2], sv[3]); b.z = cvt_pk_bf16(sv[4], sv[5]); b.w = cvt_pk_bf16(sv[6], sv[7]);
            *(u32x4*)(TC4 + (size_t)rr * 4096 + l0) = a; *(u32x4*)(TS4 + (size_t)rr * 4096 + l0) = b;
        }
        bf16_t* TC2 = (bf16_t*)(F.ws + OFF_TC2); bf16_t* TS2 = (bf16_t*)(F.ws + OFF_TS2);
        for (int rr = F.bid; rr < 256; rr += F.G) if (F.tid < 32) {
            const int l0 = 8 * F.tid; float cv[8], sv[8];
#pragma unroll
            for (int j = 0; j < 8; ++j) { const int idx = ((rr * (l0 + j)) & 255) * 16; cv[j] = tab[idx] * (1.f / 16.f); sv[j] = -tab[(idx - 1024) & 4095] * (1.f / 16.f); }
            u32x4 a, b; a.x = cvt_pk_bf16(cv[0], cv[1]); a.y = cvt_pk_bf16(cv[2], cv[3]); a.z = cvt_pk_bf16(cv[4], cv[5]); a.w = cvt_pk_bf16(cv[6], cv[7]);
            b.x = cvt_pk_bf16(sv[0], sv[1]); b.y = cvt_pk_bf16(sv[2], sv[3]); b.z = cvt_pk_bf16(sv[4], sv[5]); b.w = cvt_pk_bf16(sv[6], sv[7]);
            *(u32x4*)(TC2 + (size_t)rr * 256 + l0) = a; *(u32x4*)(TS2 + (size_t)rr * 256 + l0) = b;
        }
    }
    {
        float* wrow = (float*)(F.lds + 16384);
        for (int u = F.bid; u < 256; u += F.G) {
            const int l = u >> 7, k0 = 8 * (u & 127);
            __syncthreads();
            for (int e = F.tid; e < 2048; e += NTHREADS) wrow[e] = F.in[18][(size_t)l * DM * 1536 + (size_t)(k0 + (e >> 8)) * 1536 + 1280 + (e & 255)];
            __syncthreads();
            const int n2 = F.tid, nn = n2 & 255, sh = (n2 >= 256) ? 1024 : 0;
            float a[8] = {0.f, 0.f, 0.f, 0.f, 0.f, 0.f, 0.f, 0.f};
            for (int c = 0; c < 256; ++c) { const float t = tab[((((c * nn) & 255) << 4) - sh) & 4095];
#pragma unroll
                for (int r = 0; r < 8; ++r) a[r] += wrow[r * 256 + c] * t; }
            u32x4 o; o.x = cvt_pk_bf16(a[0] * 0.0625f, a[1] * 0.0625f); o.y = cvt_pk_bf16(a[2] * 0.0625f, a[3] * 0.0625f); o.z = cvt_pk_bf16(a[4] * 0.0625f, a[5] * 0.0625f); o.w = cvt_pk_bf16(a[6] * 0.0625f, a[7] * 0.0625f);
            *(u32x4*)((bf16_t*)(F.ws + OFF_WINF) + (size_t)l * 512 * DM + (size_t)n2 * DM + k0) = o;
        }
    }
    __syncthreads();
    {
        float* sc = (float*)(F.lds);
        float* red = (float*)(F.lds + 40960);
        for (int e = F.tid; e < 9 * 1024; e += NTHREADS) { const int i = e >> 10, k = e & 1023; const float v = (i == 0) ? F.in[6][k] : F.in[5][(size_t)(i - 1) * DM + k]; sc[e] = silu_f(v); }
        __syncthreads();
        for (int u = F.bid; u < 288; u += F.G) {
            const int l = u / 144, j0 = 64 * (u % 144), jc = F.tid & 63, kg = F.tid >> 6;
            const float* W = F.in[7] + (size_t)l * DM * 9216 + j0 + jc;
            float a[9] = {0.f, 0.f, 0.f, 0.f, 0.f, 0.f, 0.f, 0.f, 0.f};
            for (int k0 = kg * 128; k0 < kg * 128 + 128; k0 += 16) { float wv[16];
#pragma unroll
                for (int q = 0; q < 16; ++q) wv[q] = W[(size_t)(k0 + q) * 9216];
#pragma unroll
                for (int q = 0; q < 16; ++q) {
#pragma unroll
                    for (int i = 0; i < 9; ++i) a[i] += sc[i * 1024 + k0 + q] * wv[q]; } }
#pragma unroll
            for (int i = 0; i < 9; ++i) red[(kg * 9 + i) * 64 + jc] = a[i];
            __syncthreads();
            for (int o = F.tid; o < 576; o += NTHREADS) { const int i = o >> 6, jj = o & 63; float s = 0.f;
#pragma unroll
                for (int q = 0; q < 8; ++q) s += red[(q * 9 + i) * 64 + jj];
                ((float*)(F.ws + OFF_MOD))[(size_t)(l * 9 + i) * 9216 + j0 + jj] = s + F.in[8][(size_t)l * 9216 + j0 + jj]; }
            __syncthreads();
        }
    }
    {
        const size_t gt = (size_t)F.bid * NTHREADS + F.tid, GT = (size_t)F.G * NTHREADS;
        for (size_t e = gt; e < (size_t)2 * 2 * 8 * 2 * 4096; e += GT) {
            const int ch = (int)(e & 4095); size_t r = e >> 12; const int kv = r & 1; r >>= 1; const int b = r & 7; r >>= 3; const int g = r & 1; const int l = (int)(r >> 1);
            const float* src = F.in[2 + g] + ((((size_t)b * 2 + l) * 2 + kv) * 32768) + (size_t)ch * 8;
            const f32x4 v0 = *(const f32x4*)src, v1 = *(const f32x4*)(src + 4);
            u32x4 o; o.x = cvt_pk_bf16(v0[0], v0[1]); o.y = cvt_pk_bf16(v0[2], v0[3]); o.z = cvt_pk_bf16(v1[0], v1[1]); o.w = cvt_pk_bf16(v1[2], v1[3]);
            *(u32x4*)((bf16_t*)(F.ws + OFF_CKV) + e * 8) = o;
        }
        for (size_t e = gt; e < (size_t)4096 * 32; e += GT) { const int pos = (int)(e >> 5), i = (int)(e & 31), f = i & 15;
            const float inv = powf(10000.0f, -(float)f * (1.0f / 16.0f)); const float ang = (float)(i < 16 ? (pos >> 6) : (pos & 63)) * inv;
            ((f32x2*)(F.ws + OFF_ROPE))[e] = (f32x2){cosf(ang), sinf(ang)}; }
        for (size_t e = (size_t)((F.bid + F.G / 2) % F.G) * NTHREADS + F.tid; e < (size_t)2 * 2 * 16 * 64 * 8; e += GT) {
            const int sb = (int)(e & 7), p = (int)((e >> 3) & 63), g = (int)((e >> 9) & 15), dir = (int)((e >> 13) & 1), l = (int)(e >> 14);
            const int pi = ((l * 2 + dir) * 16 + g) * 64 + p;
            const float lre = F.in[20][pi], lim = F.in[21][pi], dt = __expf(F.in[26][(l * 2 + dir) * 16 + g]);
            const float er = expf(lre * dt); float sn, cs; sincosf(lim * dt, &sn, &cs);
            const float ar = er * cs, ai = er * sn, nr = ar - 1.f, ni = ai, dd = 1.f / (lre * lre + lim * lim);
            const float qr = (nr * lre + ni * lim) * dd, qi = (ni * lre - nr * lim) * dd;
            float br[16], bi[16];
#pragma unroll
            for (int c4 = 0; c4 < 4; ++c4) { const f32x4 r = *(const f32x4*)(F.in[22] + (size_t)pi * 16 + 4 * c4), m = *(const f32x4*)(F.in[23] + (size_t)pi * 16 + 4 * c4);
#pragma unroll
                for (int j = 0; j < 4; ++j) { br[4 * c4 + j] = qr * r[j] - qi * m[j]; bi[4 * c4 + j] = qr * m[j] + qi * r[j]; } }
            bf16_t* wre = (bf16_t*)(F.ws + OFF_W128) + ((size_t)pi * 2) * 2048; bf16_t* wim = wre + 2048;
            for (int s_ = sb * 16; s_ < sb * 16 + 16; ++s_) {
                const float kk = (float)(dir ? s_ : 127 - s_); const float pe = expf(kk * lre * dt); float ps, pc; sincosf(kk * lim * dt, &ps, &pc);
                const float pr = pe * pc, pim = pe * ps;
                u32x4 a0, a1, b0, b1;
                a0.x = cvt_pk_bf16(pr * br[0] - pim * bi[0], pr * br[1] - pim * bi[1]); a0.y = cvt_pk_bf16(pr * br[2] - pim * bi[2], pr * br[3] - pim * bi[3]);
                a0.z = cvt_pk_bf16(pr * br[4] - pim * bi[4], pr * br[5] - pim * bi[5]); a0.w = cvt_pk_bf16(pr * br[6] - pim * bi[6], pr * br[7] - pim * bi[7]);
                a1.x = cvt_pk_bf16(pr * br[8] - pim * bi[8], pr * br[9] - pim * bi[9]); a1.y = cvt_pk_bf16(pr * br[10] - pim * bi[10], pr * br[11] - pim * bi[11]);
                a1.z = cvt_pk_bf16(pr * br[12] - pim * bi[12], pr * br[13] - pim * bi[13]); a1.w = cvt_pk_bf16(pr * br[14] - pim * bi[14], pr * br[15] - pim * bi[15]);
                b0.x = cvt_pk_bf16(pr * bi[0] + pim * br[0], pr * bi[1] + pim * br[1]); b0.y = cvt_pk_bf16(pr * bi[2] + pim * br[2], pr * bi[3] + pim * br[3]);
                b0.z = cvt_pk_bf16(pr * bi[4] + pim * br[4], pr * bi[5] + pim * br[5]); b0.w = cvt_pk_bf16(pr * bi[6] + pim * br[6], pr * bi[7] + pim * br[7]);
                b1.x = cvt_pk_bf16(pr * bi[8] + pim * br[8], pr * bi[9] + pim * br[9]); b1.y = cvt_pk_bf16(pr * bi[10] + pim * br[10], pr * bi[11] + pim * br[11]);
                b1.z = cvt_pk_bf16(pr * bi[12] + pim * br[12], pr * bi[13] + pim * br[13]); b1.w = cvt_pk_bf16(pr * bi[14] + pim * br[14], pr * bi[15] + pim * br[15]);
                *(u32x4*)(wre + 16 * s_) = a0; *(u32x4*)(wre + 16 * s_ + 8) = a1; *(u32x4*)(wim + 16 * s_) = b0; *(u32x4*)(wim + 16 * s_ + 8) = b1;
            }
        }
    }
}

DI void norm_phase(unsigned char* lds_, int wv_, int l, int which, bool first) {
    Frame F = mkframe(lds_, wv_);
    const float* h0 = F.in[0]; const float* h1 = F.in[1]; const bf16_t* HB = (const bf16_t*)(F.ws + OFF_HB);
    const float* gvec = F.in[which == 0 ? 9 : which == 1 ? 10 : 11] + l * DM; const float* modl = (const float*)(F.ws + OFF_MOD) + (size_t)l * 9 * 9216; const int jsh = which * 3, jsc = which * 3 + 1;
    const int gw = F.bid * NWAVES + F.wave, NGW = F.G * NWAVES;
    bf16_t* XN = (bf16_t*)(F.out);
    f32x4 gv[4];
#pragma unroll
    for (int j = 0; j < 4; ++j) gv[j] = *(const f32x4*)(gvec + 4 * F.lane + 256 * j);
    for (int row0 = gw * 4; row0 < T_ALL; row0 += NGW * 4) {
        f32x4 v[4][4]; float s[4];
#pragma unroll
        for (int r = 0; r < 4; ++r) { const int row = row0 + r;
            if (first) { const float* src = row < T_CTX ? h0 + (size_t)row * DM : h1 + (size_t)(row - T_CTX) * DM;
#pragma unroll
                for (int j = 0; j < 4; ++j) v[r][j] = __builtin_nontemporal_load((const f32x4*)(src + 4 * F.lane + 256 * j)); }
            else {
#pragma unroll
                for (int j = 0; j < 4; ++j) { const u32x2 w = __builtin_nontemporal_load((const u32x2*)(HB + (size_t)row * DM + 4 * F.lane + 256 * j)); v[r][j] = (f32x4){bflo(w.x), bfhi(w.x), bflo(w.y), bfhi(w.y)}; } } }
#pragma unroll
        for (int r = 0; r < 4; ++r) { float a = 0.f;
#pragma unroll
            for (int j = 0; j < 4; ++j) a += (v[r][j].x * v[r][j].x + v[r][j].y * v[r][j].y) + (v[r][j].z * v[r][j].z + v[r][j].w * v[r][j].w);
            s[r] = a; }
#pragma unroll
        for (int o = 1; o < 64; o <<= 1) {
#pragma unroll
            for (int r = 0; r < 4; ++r) s[r] += shx(s[r], o, F.lane); }
#pragma unroll
        for (int r = 0; r < 4; ++r) { const int row = row0 + r;
            const int cond = row < T_CTX ? 0 : 1 + ((row - T_CTX) >> 12);
            const float* shp = modl + (size_t)cond * 9216 + jsh * 1024; const float* scp = modl + (size_t)cond * 9216 + jsc * 1024;
            const float rstd = rsqrtf(s[r] * (1.f / DM) + EPSF);
#pragma unroll
            for (int j = 0; j < 4; ++j) { const f32x4 sh = *(const f32x4*)(shp + 4 * F.lane + 256 * j), sc = *(const f32x4*)(scp + 4 * F.lane + 256 * j);
                const f32x4 o = (v[r][j] * rstd * gv[j]) * (sc + 1.f) + sh;
                u32x2 w; w.x = cvt_pk_bf16(o.x, o.y); w.y = cvt_pk_bf16(o.z, o.w);
                *(u32x2*)(XN + (size_t)row * DM + 4 * F.lane + 256 * j) = w; } }
    }
}
DI void final_norm_phase(unsigned char* lds_, int wv_) {
    Frame F = mkframe(lds_, wv_);
    const int gw = F.bid * NWAVES + F.wave, NGW = F.G * NWAVES;
    f32x4 gv[4];
#pragma unroll
    for (int j = 0; j < 4; ++j) gv[j] = *(const f32x4*)(F.in[35] + 4 * F.lane + 256 * j);
    for (int row0 = gw * 4; row0 < T_ALL; row0 += NGW * 4) {
        f32x4 v[4][4]; float s[4];
#pragma unroll
        for (int r = 0; r < 4; ++r) { const float* p = F.out + (size_t)(row0 + r) * DM;
#pragma unroll
            for (int j = 0; j < 4; ++j) v[r][j] = *(const f32x4*)(p + 4 * F.lane + 256 * j); }
#pragma unroll
        for (int r = 0; r < 4; ++r) { float a = 0.f;
#pragma unroll
            for (int j = 0; j < 4; ++j) a += (v[r][j].x * v[r][j].x + v[r][j].y * v[r][j].y) + (v[r][j].z * v[r][j].z + v[r][j].w * v[r][j].w);
            s[r] = a; }
#pragma unroll
        for (int o = 1; o < 64; o <<= 1) {
#pragma unroll
            for (int r = 0; r < 4; ++r) s[r] += shx(s[r], o, F.lane); }
#pragma unroll
        for (int r = 0; r < 4; ++r) { float* p = F.out + (size_t)(row0 + r) * DM; const float rstd = rsqrtf(s[r] * (1.f / DM) + EPSF);
#pragma unroll
            for (int j = 0; j < 4; ++j) __builtin_nontemporal_store(v[r][j] * rstd * gv[j], (f32x4*)(p + 4 * F.lane + 256 * j)); }
    }
}

DI void kprep_phase(unsigned char* lds_, int wv_, int l) {
    Frame F = mkframe(lds_, wv_);
    const int gw = F.bid * NWAVES + F.wave, NGW = F.G * NWAVES;
    const bf16_t* PROJ = (const bf16_t*)(F.ws + OFF_PROJ); bf16_t* KR = (bf16_t*)(F.ws + OFF_KR);
    const f32x2* ROPE = (const f32x2*)(F.ws + OFF_ROPE);
    const int hk = F.lane >> 5, i = F.lane & 31;
    const float gk0 = F.in[32][l * 64 + i], gk1 = F.in[32][l * 64 + i + 32];
    bf16_t n0 = 0, n1 = 0, n2 = 0, n3 = 0;
    if (gw < T_ALL) { const bf16_t* p0 = PROJ + (size_t)gw * NPROJ; n0 = p0[512 + hk * 64 + i]; n1 = p0[512 + hk * 64 + i + 32]; n2 = p0[1024 + hk * 64 + i]; n3 = p0[1024 + hk * 64 + i + 32]; }
    for (int tok = gw; tok < T_ALL; tok += NGW) {
        const bf16_t* pr = PROJ + (size_t)tok * NPROJ;
        float s1 = bf1(n0), s2 = bf1(n1);
        float a1 = bf1(n2), a2 = bf1(n3);
        if (tok + NGW < T_ALL) { const bf16_t* pn = pr + (size_t)NGW * NPROJ; n0 = pn[512 + hk * 64 + i]; n1 = pn[512 + hk * 64 + i + 32]; n2 = pn[1024 + hk * 64 + i]; n3 = pn[1024 + hk * 64 + i + 32]; }
        float ss = a1 * a1 + a2 * a2;
#pragma unroll
        for (int o = 1; o < 32; o <<= 1) ss += shx(ss, o, F.lane);
        const float rn = rsqrtf(ss * (1.f / 64.f) + EPSF);
        a1 = a1 * rn * gk0; a2 = a2 * rn * gk1;
        if (tok >= T_CTX) {
            const int pos = (tok - T_CTX) & 4095; const f32x2 cs = ROPE[pos * 32 + i];
            const float r1 = s1 * cs.x - s2 * cs.y, r2 = s2 * cs.x + s1 * cs.y; s1 = r1; s2 = r2;
            const float q1 = a1 * cs.x - a2 * cs.y, q2 = a2 * cs.x + a1 * cs.y; a1 = q1; a2 = q2;
        } else {
            const int b = tok >> 8, t = tok & 255;
            float* os = F.out + OUT_SWA + ((((size_t)b * 2 + l) * 2 + 0) * 256 + t) * 128;
            float* oa = F.out + OUT_AX + ((((size_t)b * 2 + l) * 2 + 0) * 256 + t) * 128;
            os[hk * 64 + i] = s1; os[hk * 64 + i + 32] = s2; oa[hk * 64 + i] = a1; oa[hk * 64 + i + 32] = a2;
            const unsigned vs = *(const unsigned*)(pr + 640 + 2 * F.lane), va = *(const unsigned*)(pr + 1152 + 2 * F.lane);
            *(f32x2*)(os + 32768 + 2 * F.lane) = (f32x2){bflo(vs), bfhi(vs)};
            *(f32x2*)(oa + 32768 + 2 * F.lane) = (f32x2){bflo(va), bfhi(va)};
        }
        bf16_t* kr = KR + (size_t)tok * 256;
        kr[hk * 64 + i] = (bf16_t)f2bf(s1); kr[hk * 64 + i + 32] = (bf16_t)f2bf(s2);
        kr[128 + hk * 64 + i] = (bf16_t)f2bf(a1); kr[128 + hk * 64 + i + 32] = (bf16_t)f2bf(a2);
    }
}

constexpr int S5_TC = 128, S5_LDS_PER_WAVE = 13824;
struct S5Dir { f32x2 a, aT; f32x2 b[16]; };
DI void s5_load_dir(Frame& F, int l, int dir, int g, int p, S5Dir& d) {
    const int pi = ((l * 2 + dir) * 16 + g) * 64 + p;
    const float lre = F.in[20][pi], lim = F.in[21][pi], dt = __expf(F.in[26][(l * 2 + dir) * 16 + g]);
    const float er = expf(lre * dt); float sn, cs; sincosf(lim * dt, &sn, &cs);
    const float ar = er * cs, ai = er * sn;
    d.a = (f32x2){ar, ai};
    const float nr = ar - 1.f, ni = ai, dd = 1.f / (lre * lre + lim * lim);
    const float qr = (nr * lre + ni * lim) * dd, qi = (ni * lre - nr * lim) * dd;
    const float* bre = F.in[22] + (size_t)pi * 16; const float* bim = F.in[23] + (size_t)pi * 16;
#pragma unroll
    for (int c4 = 0; c4 < 4; ++c4) { const f32x4 r = *(const f32x4*)(bre + 4 * c4), m = *(const f32x4*)(bim + 4 * c4);
#pragma unroll
        for (int j = 0; j < 4; ++j) d.b[4 * c4 + j] = (f32x2){qr * r[j] - qi * m[j], qr * m[j] + qi * r[j]}; }
    float tr = ar, ti = ai;
#pragma unroll
    for (int q = 0; q < 7; ++q) { const float nr2 = tr * tr - ti * ti, ni2 = 2.f * tr * ti; tr = nr2; ti = ni2; }
    d.aT = (f32x2){tr, ti};
}
template <bool WITH_Y>
DI void s5_group(const u32x2 w, const S5Dir& d, f32x2& st, float* U, unsigned* SB, int lane) {
    *(f32x4*)(U + (lane >> 2) * 16 + 4 * (lane & 3)) = (f32x4){bflo(w.x), bfhi(w.x), bflo(w.y), bfhi(w.y)};
    asm volatile("" ::: "memory"); __builtin_amdgcn_wave_barrier(); asm volatile("" ::: "memory");
    f32x4 n0 = *(const f32x4*)(U), n1 = *(const f32x4*)(U + 4), n2 = *(const f32x4*)(U + 8), n3 = *(const f32x4*)(U + 12);
#pragma unroll 4
    for (int k = 0; k < 16; ++k) {
        const f32x4 u0 = n0, u1 = n1, u2 = n2, u3 = n3;
        { const int kn = (k + 1) & 15;
          n0 = *(const f32x4*)(U + kn * 16); n1 = *(const f32x4*)(U + kn * 16 + 4); n2 = *(const f32x4*)(U + kn * 16 + 8); n3 = *(const f32x4*)(U + kn * 16 + 12); }
        f32x2 x0 = d.b[0] * u0[0], x1 = d.b[4] * u1[0], x2 = d.b[8] * u2[0], x3 = d.b[12] * u3[0];
#pragma unroll
        for (int j = 1; j < 4; ++j) { x0 += d.b[j] * u0[j]; x1 += d.b[4 + j] * u1[j]; x2 += d.b[8 + j] * u2[j]; x3 += d.b[12 + j] * u3[j]; }
        const f32x2 bu = (x0 + x1) + (x2 + x3);
        const f32x2 sw = (f32x2){-st.y, st.x};
        st = (st * d.a.x + bu) + sw * d.a.y;
        if (WITH_Y) SB[k * 68 + lane] = cvt_pk_bf16(st.x, st.y);
    }
    asm volatile("" ::: "memory"); __builtin_amdgcn_wave_barrier(); asm volatile("" ::: "memory");
}
DI u32x2 s5_ldu(const bf16_t* PROJ, int tokbase, int g, int dir, int grp, int lane) {
    const int o = grp * 16 + (lane >> 2); const int pos = dir ? (S5_TC - 1 - o) : o;
    return *(const u32x2*)(PROJ + (size_t)(tokbase + pos) * NPROJ + g * 16 + 4 * (lane & 3));
}
DI void s5_decode(int U, bool& lat, int& b, int& g, int& c, int& NC, int& tokbase, f32x2*& E, Frame& F) {
    if (U < 1024) { lat = false; b = U >> 5; g = (U >> 1) & 15; c = U & 1; NC = 2; tokbase = b * 256 + c * S5_TC; E = (f32x2*)(F.ws + OFF_ESTC) + (size_t)((b * 16 + g) * 2) * 2 * 64; }
    else { const int V = U - 1024; lat = true; b = V >> 9; g = (V >> 5) & 15; c = V & 31; NC = 32; tokbase = T_CTX + b * 4096 + c * S5_TC; E = (f32x2*)(F.ws + OFF_ESTL) + (size_t)((b * 16 + g) * 2) * 32 * 64; }
}
DI void s5_pass1(unsigned char* lds_, int wv_, int l) {
    Frame F = mkframe(lds_, wv_);
    const bf16_t* PROJ = (const bf16_t*)(F.ws + OFF_PROJ);
    const int lane = F.lane, n = lane & 15, kq = lane >> 4;
    const int xcd = F.bid & 7, slot = F.bid >> 3, nslot = (F.G + 7) >> 3;
    for (int t = slot; t < 80; t += nslot) {
        const int gd = 4 * xcd + t / 20, nt = t % 20, dir = gd & 1, g = gd >> 1;
        const bf16_t* A = (const bf16_t*)(F.ws + OFF_W128) + ((size_t)((l * 2 + dir) * 16 + g) * 128 + 16 * F.wave + n) * 2048 + 8 * kq;
        const int chunk = 16 * nt + n;
        const bf16_t* Bp = PROJ + (size_t)(chunk * 128 + (kq >> 1)) * NPROJ + g * 16 + 8 * (kq & 1);
        f32x4 acc = (f32x4){0.f, 0.f, 0.f, 0.f};
#pragma unroll 1
        for (int k0 = 0; k0 < 64; k0 += 16) {
            bf16x8 bf[16], af[16];
#pragma unroll
            for (int q = 0; q < 16; ++q) { bf[q] = *(const bf16x8*)(Bp + (size_t)(k0 + q) * (2 * NPROJ)); af[q] = *(const bf16x8*)(A + 32 * (k0 + q)); }
#pragma unroll
            for (int q = 0; q < 16; ++q) acc = __builtin_amdgcn_mfma_f32_16x16x32_bf16(af[q], bf[q], acc, 0, 0, 0);
        }
        f32x2* E; int NC, c;
        if (chunk < 64) { const int b = chunk >> 1; c = chunk & 1; NC = 2; E = (f32x2*)(F.ws + OFF_ESTC) + (size_t)((b * 16 + g) * 2) * 2 * 64; }
        else { const int v = chunk - 64, b = v >> 5; c = v & 31; NC = 32; E = (f32x2*)(F.ws + OFF_ESTL) + (size_t)((b * 16 + g) * 2) * 32 * 64; }
        const int j = dir ? (NC - 1 - c) : c;
        f32x2* Ej = E + (size_t)(dir * NC + j) * 64 + 8 * F.wave + 2 * kq;
        Ej[0] = (f32x2){acc[0], acc[1]}; Ej[1] = (f32x2){acc[2], acc[3]};
    }
}
typedef short s16x4 __attribute__((ext_vector_type(4)));
DI void s5_pass2(unsigned char* lds_, int wv_, int l) {
    Frame F = mkframe(lds_, wv_);
    const int gw = F.bid * NWAVES + F.wave, NGW = F.G * NWAVES;
    const bf16_t* PROJ = (const bf16_t*)(F.ws + OFF_PROJ); bf16_t* YS = (bf16_t*)(F.ws + OFF_YS);
    unsigned char* wl = F.lds + F.wave * S5_LDS_PER_WAVE;
    unsigned* SB = (unsigned*)(wl + 1024); float* YL = (float*)(wl + 5376);
    const int lane = F.lane, tk = lane & 15, rq = lane >> 4;
    unsigned* qctr = (unsigned*)(F.ws + OFF_CTL) + 3600 + 64 * l;
    (void)gw; (void)NGW;
    for (;;) {
        unsigned Uq = 0u; if (lane == 0) Uq = __hip_atomic_fetch_add(qctr, 1u, __ATOMIC_RELAXED, __HIP_MEMORY_SCOPE_AGENT);
        const int U = __builtin_amdgcn_readfirstlane((int)Uq);
        if (U >= 5120) break;
        bool lat; int b, g, c, NC, tokbase; f32x2* E; s5_decode(U, lat, b, g, c, NC, tokbase, E, F);
        for (int dir = 0; dir < 2; ++dir) {
            const int j = dir ? (NC - 1 - c) : c;
            f32x2 av, aT;
            { const int pi = ((l * 2 + dir) * 16 + g) * 64 + lane;
              const float lre = F.in[20][pi], lim = F.in[21][pi], dt = __expf(F.in[26][(l * 2 + dir) * 16 + g]);
              const float er = expf(lre * dt); float sn, cs; sincosf(lim * dt, &sn, &cs); av = (f32x2){er * cs, er * sn};
              float tr = av.x, ti = av.y;
#pragma unroll
              for (int q = 0; q < 7; ++q) { const float nr2 = tr * tr - ti * ti, ni2 = 2.f * tr * ti; tr = nr2; ti = ni2; }
              aT = (f32x2){tr, ti}; }
            bf16x8 cf[4];
            { const float* cre = F.in[24] + ((size_t)((l * 2 + dir) * 16 + g) * 16 + tk) * 64; const float* cim = F.in[25] + ((size_t)((l * 2 + dir) * 16 + g) * 16 + tk) * 64;
#pragma unroll
              for (int ks = 0; ks < 4; ++ks) { const f32x4 r = *(const f32x4*)(cre + 16 * ks + 4 * rq), m = *(const f32x4*)(cim + 16 * ks + 4 * rq);
                  u32x4 w; w.x = cvt_pk_bf16(r[0], -m[0]); w.y = cvt_pk_bf16(r[1], -m[1]); w.z = cvt_pk_bf16(r[2], -m[2]); w.w = cvt_pk_bf16(r[3], -m[3]);
                  cf[ks] = __builtin_bit_cast(bf16x8, w); } }
            s16x4 bA[8];
            { const bf16_t* wb = (const bf16_t*)(F.ws + OFF_W128) + ((size_t)((l * 2 + dir) * 16 + g) * 128 + tk) * 2048 + (dir ? 0 : 16 * 127) + 4 * rq;
#pragma unroll
              for (int mt = 0; mt < 8; ++mt) bA[mt] = __builtin_bit_cast(s16x4, *(const u32x2*)(wb + (size_t)mt * 16 * 2048)); }
            f32x2 st = (f32x2){0.f, 0.f};
            if (lat) st = *(const f32x2*)(F.in[4] + ((((size_t)b * 2 + l) * 2 + dir) * 16 + g) * 128 + lane * 2);
            auto ldu = [&](int grp) -> u32x2 { const int o = grp * 16 + tk; const int pos = dir ? (S5_TC - 1 - o) : o; return *(const u32x2*)(PROJ + (size_t)(tokbase + pos) * NPROJ + g * 16 + 4 * rq); };
            u32x2 wn = ldu(0);
            const f32x4 dv = *(const f32x4*)(F.in[27] + l * 256 + g * 16 + 4 * rq);
            for (int i0 = 0; i0 < j; i0 += 8) {
                f32x2 e[8];
#pragma unroll
                for (int q = 0; q < 8; ++q) e[q] = (i0 + q < j) ? E[(size_t)(dir * NC + i0 + q) * 64 + lane] : (f32x2){0.f, 0.f};
#pragma unroll
                for (int q = 0; q < 8; ++q) if (i0 + q < j) st = (f32x2){aT.x * st.x - aT.y * st.y + e[q].x, aT.x * st.y + aT.y * st.x + e[q].y};
            }
#pragma unroll 1
            for (int grp = 0; grp < S5_TC / 16; ++grp) {
                const u32x2 w = wn; if (grp + 1 < S5_TC / 16) wn = ldu(grp + 1);
                { const s16x4 ub = __builtin_bit_cast(s16x4, w);
#pragma unroll
                  for (int mt = 0; mt < 8; ++mt) { const f32x4 dd = __builtin_amdgcn_mfma_f32_16x16x16bf16_1k(bA[mt], ub, (f32x4){0.f, 0.f, 0.f, 0.f}, 0, 0, 0);
                      u32x2 pk; pk.x = cvt_pk_bf16_c(dd[0], dd[1]); pk.y = cvt_pk_bf16_c(dd[2], dd[3]); *(u32x2*)(SB + tk * 68 + 8 * mt + 2 * rq) = pk; } }
                asm volatile("" ::: "memory"); __builtin_amdgcn_wave_barrier(); asm volatile("" ::: "memory");
                { unsigned bw[16];
#pragma unroll
                  for (int k = 0; k < 16; ++k) bw[k] = SB[k * 68 + lane];
#pragma unroll
                  for (int k = 0; k < 16; ++k) { const f32x2 bu = (f32x2){bflo(bw[k]), bfhi(bw[k])}; const f32x2 sw = (f32x2){-st.y, st.x};
                      st = (st * av.x + bu) + sw * av.y; SB[k * 68 + lane] = cvt_pk_bf16(st.x, st.y); } }
                asm volatile("" ::: "memory"); __builtin_amdgcn_wave_barrier(); asm volatile("" ::: "memory");
                f32x4 y = (f32x4){0.f, 0.f, 0.f, 0.f};
#pragma unroll
                for (int ks = 0; ks < 4; ++ks) { const bf16x8 sf = *(const bf16x8*)(SB + tk * 68 + ks * 16 + 4 * rq); y = __builtin_amdgcn_mfma_f32_16x16x32_bf16(cf[ks], sf, y, 0, 0, 0); }
                const int o = grp * 16 + tk; const int pos = dir ? (S5_TC - 1 - o) : o;
                if (dir == 0) { *(f32x4*)(YL + pos * 16 + 4 * rq) = y; }
                else {
                    const f32x4 yf = *(const f32x4*)(YL + pos * 16 + 4 * rq);
                    const float y0 = gelu_tanh(y[0] + yf[0] + dv[0] * bflo(w.x)), y1 = gelu_tanh(y[1] + yf[1] + dv[1] * bfhi(w.x));
                    const float y2 = gelu_tanh(y[2] + yf[2] + dv[2] * bflo(w.y)), y3 = gelu_tanh(y[3] + yf[3] + dv[3] * bfhi(w.y));
                    u32x2 ov; ov.x = cvt_pk_bf16(y0, y1); ov.y = cvt_pk_bf16(y2, y3);
                    *(u32x2*)(YS + (size_t)(tokbase + pos) * 256 + g * 16 + 4 * rq) = ov;
                }
                asm volatile("" ::: "memory"); __builtin_amdgcn_wave_barrier(); asm volatile("" ::: "memory");
            }
            if (!lat && j == NC - 1) *(f32x2*)(F.out + OUT_SSM + ((((size_t)b * 2 + l) * 2 + dir) * 16 + g) * 128 + lane * 2) = st;
        }
    }
}

constexpr int AT_ROWB = 144, AT_TILEB = 64 * AT_ROWB, AT_BUFB = 2 * AT_TILEB;
DI int crow(int r, int hi) { return (r & 3) + 8 * (r >> 2) + 4 * hi; }
DI void attn_unit(Frame& F, int l, int g, bool lat, int b, int hk, int qb) {
    const bf16_t* PROJ = (const bf16_t*)(F.ws + OFF_PROJ); const bf16_t* KR = (const bf16_t*)(F.ws + OFF_KR);
    bf16_t* MERGED = (bf16_t*)(F.ws + OFF_MERGED);
    const int lane = F.lane, w = F.wave, r32 = lane & 31, hi = lane >> 5, tid = F.tid;
    const int hq = hk * 2 + (w >> 2), qrow = 32 * (w & 3) + r32, q0 = qb * 128;
    const int seq0 = lat ? T_CTX + b * 4096 : b * 256;
    const int tok = seq0 + q0 + qrow, qpos = q0 + qrow;
    bf16x8 qr[4];
    {
        bf16x8 qn[4];
        const bf16_t* qp = PROJ + (size_t)tok * NPROJ + (g ? 768 : 256) + hq * 64;
        float q[4][8]; float ss = 0.f;
#pragma unroll
        for (int s = 0; s < 4; ++s) { const u32x4 v = *(const u32x4*)(qp + 16 * s + 8 * hi);
            q[s][0] = bflo(v.x); q[s][1] = bfhi(v.x); q[s][2] = bflo(v.y); q[s][3] = bfhi(v.y); q[s][4] = bflo(v.z); q[s][5] = bfhi(v.z); q[s][6] = bflo(v.w); q[s][7] = bfhi(v.w);
#pragma unroll
            for (int j = 0; j < 8; ++j) ss += q[s][j] * q[s][j]; }
        if (g) { ss += shx(ss, 32, lane); const float rn = rsqrtf(ss * (1.f / 64.f) + EPSF);
#pragma unroll
            for (int s = 0; s < 4; ++s) { const f32x4 g0 = *(const f32x4*)(F.in[31] + l * 64 + 16 * s + 8 * hi), g1 = *(const f32x4*)(F.in[31] + l * 64 + 16 * s + 8 * hi + 4);
#pragma unroll
                for (int j = 0; j < 4; ++j) { q[s][j] *= rn * g0[j]; q[s][4 + j] *= rn * g1[j]; } } }
#pragma unroll
        for (int s = 0; s < 4; ++s) { u32x4 wv; wv.x = cvt_pk_bf16(q[s][0] * C2, q[s][1] * C2); wv.y = cvt_pk_bf16(q[s][2] * C2, q[s][3] * C2); wv.z = cvt_pk_bf16(q[s][4] * C2, q[s][5] * C2); wv.w = cvt_pk_bf16(q[s][6] * C2, q[s][7] * C2);
            qn[s] = __builtin_bit_cast(bf16x8, wv); }
        if (lat) {
            const f32x2* rp = (const f32x2*)(F.ws + OFF_ROPE) + (size_t)qpos * 32;
#pragma unroll
            for (int s = 0; s < 2; ++s) { float o1[8], o2[8];
#pragma unroll
                for (int j = 0; j < 8; ++j) { const f32x2 cs = rp[16 * s + 8 * hi + j]; const float x1 = q[s][j], x2 = q[s + 2][j]; o1[j] = (x1 * cs.x - x2 * cs.y) * C2; o2[j] = (x2 * cs.x + x1 * cs.y) * C2; }
                u32x4 w1, w2; w1.x = cvt_pk_bf16(o1[0], o1[1]); w1.y = cvt_pk_bf16(o1[2], o1[3]); w1.z = cvt_pk_bf16(o1[4], o1[5]); w1.w = cvt_pk_bf16(o1[6], o1[7]);
                w2.x = cvt_pk_bf16(o2[0], o2[1]); w2.y = cvt_pk_bf16(o2[2], o2[3]); w2.z = cvt_pk_bf16(o2[4], o2[5]); w2.w = cvt_pk_bf16(o2[6], o2[7]);
                qr[s] = __builtin_bit_cast(bf16x8, w1); qr[s + 2] = __builtin_bit_cast(bf16x8, w2); }
        } else {
#pragma unroll
            for (int s = 0; s < 4; ++s) qr[s] = qn[s];
        }
#pragma unroll
        for (int s = 0; s < 4; ++s) *(bf16x8*)(F.lds + 40960 + w * 4096 + s * 1024 + lane * 16) = qn[s];
    }
    int kstart = 0, nt0, nt1;
    if (!lat) { nt0 = 4; nt1 = 0; }
    else if (g == 0) { kstart = q0 - 128 < 0 ? 0 : q0 - 128; const int ke = q0 + 256 > 4096 ? 4096 : q0 + 256; nt0 = (ke - kstart) >> 6; nt1 = 4; }
    else { nt0 = 64; nt1 = 4; }
    const int NT = nt0 + nt1;
    const bf16_t* K0 = KR + (size_t)(seq0 + kstart) * 256 + g * 128 + hk * 64;
    const bf16_t* V0 = PROJ + (size_t)(seq0 + kstart) * NPROJ + (g ? 1152 : 640) + hk * 64;
    const bf16_t* K1 = (const bf16_t*)(F.ws + OFF_CKV) + ((((size_t)(l * 2 + g) * 8 + b) * 2 + 0) * 256) * 128 + hk * 64;
    const bf16_t* V1 = K1 + 256 * 128;
    const int lkey = tid >> 3, lch = tid & 7;
    const unsigned ko0 = (unsigned)lkey * 512u + (unsigned)lch * 16u, vo0 = (unsigned)lkey * (NPROJ * 2u) + (unsigned)lch * 16u, o1_ = (unsigned)lkey * 256u + (unsigned)lch * 16u;
    auto ldk = [&](int ti) -> u32x4 { const bool a = ti < nt0; const char* base = a ? (const char*)K0 + (size_t)ti * (64 * 512) : (const char*)K1 + (size_t)(ti - nt0) * (64 * 256); const unsigned off = a ? ko0 : o1_; return *(const u32x4*)(base + off); };
    auto ldv = [&](int ti) -> u32x4 { const bool a = ti < nt0; const char* base = a ? (const char*)V0 + (size_t)ti * (64 * NPROJ * 2) : (const char*)V1 + (size_t)(ti - nt0) * (64 * 256); const unsigned off = a ? vo0 : o1_; return *(const u32x4*)(base + off); };
    auto stage = [&](int buf, const u32x4& kv, const u32x4& vv) {
        unsigned char* kb = F.lds + buf * AT_BUFB; unsigned char* vb = kb + AT_TILEB;
        *(u32x4*)(kb + lkey * AT_ROWB + lch * 16) = kv;
        bf16_t* vt = (bf16_t*)vb + (lkey ^ (lch << 3));
        const int d0 = lch * 8;
        vt[(d0 + 0) * 72] = (bf16_t)(vv.x & 0xffff); vt[(d0 + 1) * 72] = (bf16_t)(vv.x >> 16); vt[(d0 + 2) * 72] = (bf16_t)(vv.y & 0xffff); vt[(d0 + 3) * 72] = (bf16_t)(vv.y >> 16);
        vt[(d0 + 4) * 72] = (bf16_t)(vv.z & 0xffff); vt[(d0 + 5) * 72] = (bf16_t)(vv.z >> 16); vt[(d0 + 6) * 72] = (bf16_t)(vv.w & 0xffff); vt[(d0 + 7) * 72] = (bf16_t)(vv.w >> 16);
    };
    float mrun, lrun;
    if (g == 0) { mrun = F.in[30][l * 4 + hq] * LOG2E; lrun = hi ? 0.f : 1.f; } else { mrun = -1e30f; lrun = 0.f; }
    f32x16 o0, o1;
#pragma unroll
    for (int r = 0; r < 16; ++r) { o0[r] = 0.f; o1[r] = 0.f; }
    __syncthreads();
    u32x4 kreg = ldk(0), vreg = ldv(0);
    stage(0, kreg, vreg);
    if (NT > 1) { kreg = ldk(1); vreg = ldv(1); }
    __syncthreads();
    const bool band = lat && g == 0;
    for (int ti = 0; ti < NT; ++ti) {
        const unsigned char* kb = F.lds + (ti & 1) * AT_BUFB; const unsigned char* vb = kb + AT_TILEB;
        const bool s1 = ti >= nt0;
        if (ti == nt0) {
#pragma unroll
            for (int s = 0; s < 4; ++s) qr[s] = *(const bf16x8*)(F.lds + 40960 + w * 4096 + s * 1024 + lane * 16);
        }
        f32x16 p0, p1;
#pragma unroll
        for (int r = 0; r < 16; ++r) { p0[r] = 0.f; p1[r] = 0.f; }
#pragma unroll
        for (int s = 0; s < 4; ++s) {
            const bf16x8 ka = *(const bf16x8*)(kb + r32 * AT_ROWB + (16 * s + 8 * hi) * 2);
            const bf16x8 kc = *(const bf16x8*)(kb + (32 + r32) * AT_ROWB + (16 * s + 8 * hi) * 2);
            const bf16x8 qf = qr[s];
            p0 = __builtin_amdgcn_mfma_f32_32x32x16_bf16(ka, qf, p0, 0, 0, 0);
            p1 = __builtin_amdgcn_mfma_f32_32x32x16_bf16(kc, qf, p1, 0, 0, 0);
        }
        if (band && !s1) {
            const int kp0 = kstart + ti * 64;
#pragma unroll
            for (int r = 0; r < 16; ++r) { const int kp = kp0 + crow(r, hi); int dlt = qpos - kp; dlt = dlt < 0 ? -dlt : dlt; if (dlt > 128) p0[r] = -1e30f; int d2 = qpos - kp - 32; d2 = d2 < 0 ? -d2 : d2; if (d2 > 128) p1[r] = -1e30f; }
        }
        float rm = fmaxf(p0[0], p1[0]);
#pragma unroll
        for (int r = 1; r < 16; ++r) rm = fmaxf(rm, fmaxf(p0[r], p1[r]));
        rm = fmaxf(rm, shx(rm, 32, lane));
        const float mnew = fmaxf(mrun, rm), alpha = __builtin_amdgcn_exp2f(mrun - mnew); mrun = mnew;
        float rs = 0.f;
#pragma unroll
        for (int r = 0; r < 16; ++r) { p0[r] = __builtin_amdgcn_exp2f(p0[r] - mnew); p1[r] = __builtin_amdgcn_exp2f(p1[r] - mnew); rs += p0[r] + p1[r]; }
        lrun = lrun * alpha + rs;
        if (__builtin_amdgcn_ballot_w64(alpha != 1.0f) != 0ull) {
#pragma unroll
            for (int r = 0; r < 16; ++r) { o0[r] *= alpha; o1[r] *= alpha; }
        }
        bf16x8 pf[4];
        { u32x4 a; a.x = cvt_pk_bf16(p0[0], p0[1]); a.y = cvt_pk_bf16(p0[2], p0[3]); a.z = cvt_pk_bf16(p0[4], p0[5]); a.w = cvt_pk_bf16(p0[6], p0[7]); pf[0] = __builtin_bit_cast(bf16x8, a);
          a.x = cvt_pk_bf16(p0[8], p0[9]); a.y = cvt_pk_bf16(p0[10], p0[11]); a.z = cvt_pk_bf16(p0[12], p0[13]); a.w = cvt_pk_bf16(p0[14], p0[15]); pf[1] = __builtin_bit_cast(bf16x8, a);
          a.x = cvt_pk_bf16(p1[0], p1[1]); a.y = cvt_pk_bf16(p1[2], p1[3]); a.z = cvt_pk_bf16(p1[4], p1[5]); a.w = cvt_pk_bf16(p1[6], p1[7]); pf[2] = __builtin_bit_cast(bf16x8, a);
          a.x = cvt_pk_bf16(p1[8], p1[9]); a.y = cvt_pk_bf16(p1[10], p1[11]); a.z = cvt_pk_bf16(p1[12], p1[13]); a.w = cvt_pk_bf16(p1[14], p1[15]); pf[3] = __builtin_bit_cast(bf16x8, a); }
#pragma unroll
        for (int ks = 0; ks < 4; ++ks) {
            const int ka = (16 * ks + 4 * hi) ^ ((r32 >> 3) << 3), kc = ka ^ 32;
            const unsigned char* vp = vb + r32 * AT_ROWB;
            const u32x2 a0 = *(const u32x2*)(vp + ka * 2), a1 = *(const u32x2*)(vp + (ka ^ 8) * 2);
            const u32x2 c0 = *(const u32x2*)(vp + 32 * AT_ROWB + kc * 2), c1 = *(const u32x2*)(vp + 32 * AT_ROWB + (kc ^ 8) * 2);
            const u32x4 fa = (u32x4){a0.x, a0.y, a1.x, a1.y}, fc = (u32x4){c0.x, c0.y, c1.x, c1.y};
            o0 = __builtin_amdgcn_mfma_f32_32x32x16_bf16(__builtin_bit_cast(bf16x8, fa), pf[ks], o0, 0, 0, 0);
            o1 = __builtin_amdgcn_mfma_f32_32x32x16_bf16(__builtin_bit_cast(bf16x8, fc), pf[ks], o1, 0, 0, 0);
        }
        if (ti + 1 < NT) { stage((ti + 1) & 1, kreg, vreg); if (ti + 2 < NT) { kreg = ldk(ti + 2); vreg = ldv(ti + 2); } }
        __syncthreads();
    }
    lrun += shx(lrun, 32, lane);
    const float inv = 1.f / lrun;
    bf16_t* op = MERGED + (size_t)tok * DM + (g ? 512 : 256) + hq * 64 + 4 * hi;
#pragma unroll
    for (int i = 0; i < 4; ++i) {
        u32x2 a; a.x = cvt_pk_bf16(o0[4 * i] * inv, o0[4 * i + 1] * inv); a.y = cvt_pk_bf16(o0[4 * i + 2] * inv, o0[4 * i + 3] * inv);
        u32x2 c; c.x = cvt_pk_bf16(o1[4 * i] * inv, o1[4 * i + 1] * inv); c.y = cvt_pk_bf16(o1[4 * i + 2] * inv, o1[4 * i + 3] * inv);
        *(u32x2*)(op + 8 * i) = a; *(u32x2*)(op + 32 + 8 * i) = c;
    }
}
DI void attn_phase(unsigned char* lds_, int wv_, int l) {
    Frame F = mkframe(lds_, wv_);
    for (int u = F.bid; u < 512; u += F.G) attn_unit(F, l, 1, true, u >> 6, (u >> 5) & 1, u & 31);
    for (int u = F.bid; u < 512; u += F.G) attn_unit(F, l, 0, true, u >> 6, (u >> 5) & 1, u & 31);
    for (int u = F.bid; u < 256; u += F.G) attn_unit(F, l, u >> 7, false, (u >> 2) & 31, (u >> 1) & 1, u & 1);
    __syncthreads();
}

DI void ph_gateup(unsigned char* lds_, int wv_, int l, int f) { Frame F = mkframe(lds_, wv_);
    pg8::SchedStd S; S.init((const unsigned char*)F.out, F.ws + OFF_WGU + (size_t)(l * 2 + f) * SZ_WGU, DM * 2, DM * 2, T_ALL, 2 * FF, F.G, F.bid);
    pg8::EpiSwiglu E{(bf16_t*)(F.ws + OFF_HID)}; pg8::gemm_phase<true>(F.ldsl, fresh(F.tid), pg8::Cfg{DM * 2, DM * 2, DM}, S, E); }
template <bool IN32, bool OUT32>
DI void down_gemms(Frame& F, const void* h0, const void* h1, void* ho, const float* gate, const unsigned char* W) {
    { pg8::SchedStd S; S.init(F.ws + OFF_HID, W, FF * 2, FF * 2, 128 * 256, DM, F.G, F.bid);
      pg8::EpiResid<IN32, OUT32> E{h0, h1, ho, gate, 0.5f}; pg8::gemm_phase<false>(F.ldsl, fresh(F.tid), pg8::Cfg{FF * 2, FF * 2, FF}, S, E); }
    { pg8::SchedHN S{(const char*)(F.ws + OFF_HID), (const char*)W, FF * 2, FF * 2, F.G, F.bid};
      pg8::EpiResidHN<IN32, OUT32> E{h0, h1, ho, gate, 0.5f}; pg8::gemm_phase_hn<false>(F.ldsl, fresh(F.tid), pg8::Cfg{FF * 2, FF * 2, FF}, S, E); }
}
DI void ph_down(unsigned char* lds_, int wv_, int l, int f, bool first) { Frame F = mkframe(lds_, wv_);
    bf16_t* HB = (bf16_t*)(F.ws + OFF_HB);
    const float* gate = (const float*)(F.ws + OFF_MOD) + (size_t)l * 9 * 9216 + (f ? 8 : 2) * 1024;
    const unsigned char* W = F.ws + OFF_WDN + (size_t)(l * 2 + f) * SZ_WDN;
    if (first) down_gemms<true, false>(F, F.in[0], F.in[1], HB, gate, W);
    else if (l == 1 && f == 1) down_gemms<false, true>(F, HB, HB + (size_t)T_CTX * DM, F.out, gate, W);
    else down_gemms<false, false>(F, HB, HB + (size_t)T_CTX * DM, HB, gate, W);
}
DI void ph_win(unsigned char* lds_, int wv_, int l) { Frame F = mkframe(lds_, wv_);
    const unsigned char* XN = (const unsigned char*)F.out; const unsigned char* WIN = F.ws + OFF_WIN + (size_t)l * NPROJ * DM * 2; const unsigned char* WINF = F.ws + OFF_WINF + (size_t)l * 512 * DM * 2;
    { pg8::SchedStd S; S.init(XN, WIN, DM * 2, DM * 2, 153 * 256, NPROJ, F.G, F.bid);
      pg8::EpiStore E{(bf16_t*)(F.ws + OFF_PROJ), NPROJ}; pg8::gemm_phase<true>(F.ldsl, fresh(F.tid), pg8::Cfg{DM * 2, DM * 2, DM}, S, E); }
    { pg8::SchedStd S; S.init(WINF, XN, DM * 2, DM * 2, 512, 128 * 256, F.G, F.bid);
      pg8::EpiStore E{(bf16_t*)(F.ws + OFF_PQT), T_ALL}; pg8::gemm_phase<true>(F.ldsl, fresh(F.tid), pg8::Cfg{DM * 2, DM * 2, DM}, S, E); }
    { pg8::SchedWinTail S{(const char*)XN, (const char*)WIN, (const char*)WINF, F.G, F.bid};
      pg8::EpiStoreHN E{(bf16_t*)(F.ws + OFF_PROJ), NPROJ, (ptrdiff_t)OFF_PQT - (ptrdiff_t)OFF_PROJ, T_ALL}; pg8::gemm_phase_hn<true>(F.ldsl, fresh(F.tid), pg8::Cfg{DM * 2, DM * 2, DM}, S, E); } }
DI void dft_row0(unsigned char* lds_, int wv_) { Frame F = mkframe(lds_, wv_);
    const int gw = F.bid * NWAVES + F.wave, NGW = F.G * NWAVES;
    const bf16_t* PQT = (const bf16_t*)(F.ws + OFF_PQT); bf16_t* FCS = (bf16_t*)(F.out);
    for (int t = gw; t < 8 * 256; t += NGW) { const int b = t >> 8, ch = t & 255; const int seq0 = T_CTX + b * 4096;
        const bf16_t* p = PQT + (size_t)ch * T_ALL + seq0 + F.lane * 8; float a = 0.f;
#pragma unroll
        for (int q = 0; q < 8; ++q) { const u32x4 v = *(const u32x4*)(p + q * 512); a += (bflo(v.x) + bfhi(v.x)) + (bflo(v.y) + bfhi(v.y)) + (bflo(v.z) + bfhi(v.z)) + (bflo(v.w) + bfhi(v.w)); }
        a = wave_sum(a, F.lane);
        if (F.lane == 0) FCS[(size_t)seq0 * 1024 + ch] = (bf16_t)f2bf(a * (1.f / 64.f));
        if (ch == 0) { bf16_t* z = FCS + (size_t)seq0 * 1024 + 256 + F.lane * 12;
            *(u32x2*)z = (u32x2){0u, 0u}; *(u32x2*)(z + 4) = (u32x2){0u, 0u}; *(u32x2*)(z + 8) = (u32x2){0u, 0u}; } }
}
DI void ph_dft(unsigned char* lds_, int wv_) { Frame F = mkframe(lds_, wv_);
    { pg8::SchedDftLat S{(const char*)(F.ws + OFF_TC4), OFF_TS4 - OFF_TC4, (const char*)(F.ws + OFF_PQT), F.G, F.bid};
      pg8::EpiDftSym E{(bf16_t*)(F.out)}; pg8::gemm_phase<true>(F.ldsl, fresh(F.tid), pg8::Cfg{8192, T_ALL * 2, 2048}, S, E); }
    { pg8::SchedDftCtx S{(const char*)(F.ws + OFF_TC2), OFF_TS2 - OFF_TC2, (const char*)(F.ws + OFF_PQT), F.G, F.bid};
      pg8::EpiDftCtx E{(bf16_t*)(F.out)}; pg8::gemm_phase<true>(F.ldsl, fresh(F.tid), pg8::Cfg{512, T_ALL * 2, 256}, S, E); } }
DI void ph_post(unsigned char* lds_, int wv_, int l) { Frame F = mkframe(lds_, wv_);
    { pg8::SchedStd S; S.init(F.ws + OFF_YS, F.ws + OFF_WGLU + (size_t)l * 65536 * 2, 512, 512, T_ALL, 256, F.G, F.bid);
      pg8::EpiGlu E{(const bf16_t*)(F.ws + OFF_YS), F.in[29] + l * 256, (bf16_t*)(F.ws + OFF_MERGED)}; pg8::gemm_phase<true>(F.ldsl, fresh(F.tid), pg8::Cfg{512, 512, 256}, S, E); }
    { pg8::SchedStd S; S.init((const unsigned char*)F.out, F.ws + OFF_WFN + (size_t)l * 256 * 1024 * 2, 2048, 2048, T_ALL, 256, F.G, F.bid);
      pg8::EpiBias E{F.in[34] + l * 256, (bf16_t*)(F.ws + OFF_MERGED), 768}; pg8::gemm_phase<true>(F.ldsl, fresh(F.tid), pg8::Cfg{2048, 2048, 1024}, S, E); } }
DI void ph_wout(unsigned char* lds_, int wv_, int l) { Frame F = mkframe(lds_, wv_);
    bf16_t* HB = (bf16_t*)(F.ws + OFF_HB); const float* gate = (const float*)(F.ws + OFF_MOD) + (size_t)l * 9 * 9216 + 5 * 1024;
    const unsigned char* W = F.ws + OFF_WOUT + (size_t)l * DM * DM * 2;
    { pg8::SchedStd S; S.init(F.ws + OFF_MERGED, W, DM * 2, DM * 2, 128 * 256, DM, F.G, F.bid);
      pg8::EpiResid<false, false> E{HB, HB + (size_t)T_CTX * DM, HB, gate, 1.0f}; pg8::gemm_phase<false>(F.ldsl, fresh(F.tid), pg8::Cfg{DM * 2, DM * 2, DM}, S, E); }
    { pg8::SchedHN S{(const char*)(F.ws + OFF_MERGED), (const char*)W, DM * 2, DM * 2, F.G, F.bid};
      pg8::EpiResidHN<false, false> E{HB, HB + (size_t)T_CTX * DM, HB, gate, 1.0f}; pg8::gemm_phase_hn<false>(F.ldsl, fresh(F.tid), pg8::Cfg{DM * 2, DM * 2, DM}, S, E); } }

__global__ void __launch_bounds__(NTHREADS, 2) mega_fwd(Params P) {
    extern __shared__ __attribute__((aligned(16))) unsigned char lds[];
    cg::grid_group grid = cg::this_grid();
#define GSYNC() do { asm volatile("s_waitcnt vmcnt(0) lgkmcnt(0)" ::: "memory"); grid.sync(); __builtin_amdgcn_fence(__ATOMIC_ACQUIRE, "agent"); asm volatile("s_waitcnt vmcnt(0)" ::: "memory"); } while (0)
    const int wv0 = __builtin_amdgcn_readfirstlane((int)(threadIdx.x >> 6));
    if (threadIdx.x == 0) {
#pragma unroll
        for (int i = 0; i < 36; ++i) *(unsigned long long*)(lds + PTAB_OFF + 8 * i) = (unsigned long long)P.in[i];
        *(unsigned long long*)(lds + PTAB_OFF + 8 * 36) = (unsigned long long)P.out; *(unsigned long long*)(lds + PTAB_OFF + 8 * 37) = (unsigned long long)P.ws;
        *(unsigned*)(lds + XBST_OFF) = 0u; *(unsigned*)(lds + XBST_OFF + 4) = 0u;
        (void)xb_add((unsigned*)(P.ws + OFF_CTL) + XB_XCNT(xb_xcc_id()), 1u); }
    __syncthreads();
#undef GSYNC
#define GSYNC() xcd_sync(lds, wv0)
    if (gridDim.x == 0x7fffffffu) grid.sync();
    p0_phase(lds, wv0);
    GSYNC();
#define FFN_PHASES(l, f, first) do { norm_phase(lds, wv0, l, (f) ? 2 : 0, first); GSYNC(); ph_gateup(lds, wv0, l, f); GSYNC(); ph_down(lds, wv0, l, f, first); GSYNC(); } while (0)
#define MIX_PHASES(l) do { norm_phase(lds, wv0, l, 1, false); GSYNC(); ph_win(lds, wv0, l); GSYNC(); kprep_phase(lds, wv0, l); s5_pass1(lds, wv0, l); GSYNC(); \
        attn_phase(lds, wv0, l); dft_row0(lds, wv0); ph_dft(lds, wv0); __syncthreads(); s5_pass2(lds, wv0, l); GSYNC(); ph_post(lds, wv0, l); GSYNC(); ph_wout(lds, wv0, l); GSYNC(); } while (0)
    FFN_PHASES(0, 0, true); MIX_PHASES(0); FFN_PHASES(0, 1, false);
    FFN_PHASES(1, 0, false); MIX_PHASES(1); FFN_PHASES(1, 1, false);
    final_norm_phase(lds, wv0);
}

extern "C" void kernel_launch(void* const* d_in, const int* in_sizes, int n_in, void* d_out, int out_size, void* d_ws, size_t ws_size, hipStream_t stream) {
    static int grid = 0;
    if (grid == 0) {
        int dev = 0, cus = 0, per_cu = 0;
        hipGetDevice(&dev);
        hipDeviceGetAttribute(&cus, hipDeviceAttributeMultiprocessorCount, dev);
        if (hipFuncSetAttribute((const void*)mega_fwd, hipFuncAttributeMaxDynamicSharedMemorySize, LDS_BYTES) != hipSuccess) { fprintf(stderr, "hipFuncSetAttribute failed\n"); }
        if (hipOccupancyMaxActiveBlocksPerMultiprocessor(&per_cu, (const void*)mega_fwd, NTHREADS, LDS_BYTES) != hipSuccess || per_cu < 1) { fprintf(stderr, "occupancy query: %d\n", per_cu); per_cu = 1; }
        (void)hipGetLastError();
        grid = cus * 1;
        if (n_in != 36 || ws_size < WS_TOTAL) { fprintf(stderr, "kernel_launch: unexpected n_in %d / ws %zu (need %zu)\n", n_in, ws_size, (size_t)WS_TOTAL); grid = -1; }
    }
    if (grid < 0) return;
    if (hipMemsetAsync((char*)d_ws + OFF_CTL, 0, CTL_BYTES, stream) != hipSuccess) { fprintf(stderr, "memset failed\n"); return; }
    Params p{};
    for (int i = 0; i < 36; ++i) p.in[i] = (const float*)d_in[i];
    p.out = (float*)d_out; p.ws = (unsigned char*)d_ws;
    void* args[] = {&p};
    hipError_t e = hipLaunchCooperativeKernel((const void*)mega_fwd, dim3(grid), dim3(NTHREADS), args, LDS_BYTES, stream);
    if (e != hipSuccess) fprintf(stderr, "cooperative launch failed: %s (grid %d)\n", hipGetErrorString(e), grid);
}
```
